# Optimizing an MI355X kernel written in HIP

```python
import math
import jax
import jax.numpy as jnp
from jax import lax
import numpy as np

D_MODEL = 1024
BATCH = 4
SEQ = 8192
DEPTH = 2

CHUNK = 64
S5_WIDTH = D_MODEL // 4
S5_GROUP_CH = 16
S5_GROUPS = S5_WIDTH // S5_GROUP_CH
S5_STATE = 64
SB_HEADS = 4
SB_HEAD_DIM = 64
SB_WIDTH = SB_HEADS * SB_HEAD_DIM
SB_BLOCK = 128
RET_HEADS = 4
RET_DK = 64
RET_DV = 128
RET_QK_WIDTH = RET_HEADS * RET_DK
RET_V_WIDTH = RET_HEADS * RET_DV
ROPE_BASE = 10000.0
N_BRANCHES = 3
IN_WIDTH = S5_WIDTH + 3 * SB_WIDTH + 2 * RET_QK_WIDTH + 2 * RET_V_WIDTH + N_BRANCHES * D_MODEL
N_EXPERTS = 16
N_EXPERT_GROUPS = 4
EXPERTS_PER_GROUP = N_EXPERTS // N_EXPERT_GROUPS
TOP_K = 2
D_EXPERT = 1024
MOE_BLOCK = 128
ALPHA = (2 * DEPTH) ** 0.25
BETA = (8 * DEPTH) ** -0.25
LN_EPS = 1e-5

kernel_name = 'hybrid_streaming_encoder'


def layer_norm(x, g, b):
    xf = x.astype(jnp.float32)
    mu = jnp.mean(xf, axis=-1, keepdims=True)
    var = jnp.mean(jnp.square(xf - mu), axis=-1, keepdims=True)
    return ((xf - mu) * lax.rsqrt(var + LN_EPS) * g + b).astype(x.dtype)


def rope(t, pos):
    half = t.shape[-1] // 2
    inv_freq = ROPE_BASE ** (-jnp.arange(half, dtype=jnp.float32) / half)
    ang = pos[:, None] * inv_freq[None, :]
    cos = jnp.cos(ang)[None, :, None, :]
    sin = jnp.sin(ang)[None, :, None, :]
    t1, t2 = t[..., :half], t[..., half:]
    return jnp.concatenate([t1 * cos - t2 * sin, t1 * sin + t2 * cos], axis=-1)


def s5_mixer(u, lam_re, lam_im, log_dt, b_re, b_im, c_re, c_im, d_skip, w_glu, b_glu):
    Bsz, L, _ = u.shape
    uf = u.astype(jnp.float32).reshape(Bsz, L, S5_GROUPS, S5_GROUP_CH)
    lam = lax.complex(lam_re.astype(jnp.float32), lam_im.astype(jnp.float32))
    dt = jnp.exp(log_dt.astype(jnp.float32))[:, None]
    lam_bar = jnp.exp(lam * dt)
    zoh = (lam_bar - 1.0) / lam
    b_bar = lax.complex(b_re.astype(jnp.float32), b_im.astype(jnp.float32)) * zoh[..., None]
    bu = lax.complex(jnp.einsum('blgc,gpc->blgp', uf, jnp.real(b_bar)),
                     jnp.einsum('blgc,gpc->blgp', uf, jnp.imag(b_bar)))
    a = jnp.broadcast_to(lam_bar, (L,) + lam_bar.shape)

    def combine(e1, e2):
        a1, s1 = e1
        a2, s2 = e2
        return a1 * a2, a2 * s1 + s2

    def scan_one(bu_b):
        return lax.associative_scan(combine, (a, bu_b))[1]

    states = jax.vmap(scan_one)(bu)
    y = (jnp.einsum('blgp,gcp->blgc', jnp.real(states), c_re.astype(jnp.float32))
         - jnp.einsum('blgp,gcp->blgc', jnp.imag(states), c_im.astype(jnp.float32))
         + d_skip.astype(jnp.float32).reshape(S5_GROUPS, S5_GROUP_CH) * uf)
    y = jax.nn.gelu(y.reshape(Bsz, L, S5_WIDTH))
    y = y * jax.nn.sigmoid(y @ w_glu.astype(jnp.float32) + b_glu.astype(jnp.float32))
    return y.astype(u.dtype)


def stick_breaking_attention(q, k, v):
    Bsz, L, H, d = q.shape
    qf = q.astype(jnp.float32) * (d ** -0.5)
    kf = k.astype(jnp.float32)
    vf = v.astype(jnp.float32)
    nqb = L // SB_BLOCK
    qb = qf.reshape(Bsz, nqb, SB_BLOCK, H, d).transpose(1, 0, 3, 2, 4)
    key_pos = jnp.arange(L)

    def block(args):
        i, qblk = args
        qpos = i * SB_BLOCK + jnp.arange(SB_BLOCK)
        z = jnp.einsum('bhqd,bkhd->bhqk', qblk, kf)
        mask = key_pos[None, :] < qpos[:, None]
        log_1m = jnp.where(mask, jax.nn.log_sigmoid(-z), 0.0)
        after = lax.cumsum(log_1m, axis=3, reverse=True) - log_1m
        w = jnp.where(mask, jnp.exp(jax.nn.log_sigmoid(z) + after), 0.0)
        return jnp.einsum('bhqk,bkhd->bqhd', w, vf)

    out = lax.map(block, (jnp.arange(nqb), qb))
    return out.transpose(1, 0, 2, 3, 4).reshape(Bsz, L, H * d)


def chunkwise_retention(q, k, v, g, gn_g):
    Bsz, L, _ = q.shape
    n_chunks = L // CHUNK
    pos = jnp.arange(L, dtype=jnp.float32)
    qf = rope(q.astype(jnp.float32).reshape(Bsz, L, RET_HEADS, RET_DK), pos)
    kf = rope(k.astype(jnp.float32).reshape(Bsz, L, RET_HEADS, RET_DK), pos) * (RET_DK ** -0.5)
    vf = v.astype(jnp.float32).reshape(Bsz, L, RET_HEADS, RET_DV)

    def to_chunks(t):
        return t.reshape(Bsz, n_chunks, CHUNK, RET_HEADS, t.shape[-1]).transpose(0, 3, 1, 2, 4)

    qc, kc, vc = to_chunks(qf), to_chunks(kf), to_chunks(vf)
    log_gamma = jnp.log(1.0 - 2.0 ** (-5.0 - jnp.arange(RET_HEADS, dtype=jnp.float32)))
    idx = jnp.arange(CHUNK, dtype=jnp.float32)
    intra_decay = jnp.exp(log_gamma[:, None, None] * jnp.abs(idx[:, None] - idx[None, :]))
    scores = jnp.einsum('bhncd,bhnsd->bhncs', qc, kc) * intra_decay[None, :, None]
    intra = jnp.einsum('bhncs,bhnse->bhnce', scores, vc)
    k_dec = kc * jnp.exp(log_gamma[:, None] * (CHUNK - 1.0 - idx))[None, :, None, :, None]
    kv = jnp.einsum('bhnsd,bhnse->nbhde', k_dec, vc)
    chunk_decay = jnp.exp(log_gamma * CHUNK)[None, :, None, None]

    def step(state, kv_i):
        return chunk_decay * state + kv_i, state

    _, state_prev = lax.scan(step, jnp.zeros_like(kv[0]), kv)
    q_dec = qc * jnp.exp(log_gamma[:, None] * (idx + 1.0))[None, :, None, :, None]
    cross = jnp.einsum('bhncd,nbhde->bhnce', q_dec, state_prev)
    o = (intra + cross).transpose(0, 2, 3, 1, 4).reshape(Bsz, L, RET_HEADS, RET_DV)
    mu = jnp.mean(o, axis=-1, keepdims=True)
    var = jnp.mean(jnp.square(o - mu), axis=-1, keepdims=True)
    o = ((o - mu) * lax.rsqrt(var + LN_EPS)).reshape(Bsz, L, RET_V_WIDTH) * gn_g.astype(jnp.float32)
    return jax.nn.silu(g.astype(jnp.float32)) * o


def hybrid_mixer(x, w_in, lam_re, lam_im, log_dt, b_re, b_im, c_re, c_im, d_skip, w_glu, b_glu,
                 gn_g, w_up_a, w_up_b, w_up_c, w_out):
    Bsz, L, _ = x.shape
    h = x @ w_in
    sizes = (S5_WIDTH, SB_WIDTH, SB_WIDTH, SB_WIDTH, RET_QK_WIDTH, RET_QK_WIDTH,
             RET_V_WIDTH, RET_V_WIDTH, D_MODEL, D_MODEL, D_MODEL)
    cuts = np.cumsum(sizes)[:-1].tolist()
    u_a, q_b, k_b, v_b, q_c, k_c, v_c, g_c, gate_a, gate_b, gate_c = jnp.split(h, cuts, axis=-1)
    y_a = s5_mixer(u_a, lam_re, lam_im, log_dt, b_re, b_im, c_re, c_im, d_skip, w_glu, b_glu)
    hd = (Bsz, L, SB_HEADS, SB_HEAD_DIM)
    y_b = stick_breaking_attention(q_b.reshape(hd), k_b.reshape(hd), v_b.reshape(hd)).astype(x.dtype)
    y_c = chunkwise_retention(q_c, k_c, v_c, g_c, gn_g).astype(x.dtype)
    merged = (jax.nn.sigmoid(gate_a) * (y_a @ w_up_a)
              + jax.nn.sigmoid(gate_b) * (y_b @ w_up_b)
              + jax.nn.sigmoid(gate_c) * (y_c @ w_up_c))
    return merged @ w_out


def grouped_moe(x, router_w, router_b, w1, w3, w2):
    Bsz, L, D = x.shape
    T = Bsz * L
    xt = x.reshape(T, D)
    logits = (xt @ router_w).astype(jnp.float32) + router_b.astype(jnp.float32)
    scores = jax.nn.softmax(logits, axis=-1)
    grp_score = lax.top_k(scores.reshape(T, N_EXPERT_GROUPS, EXPERTS_PER_GROUP), 2)[0].sum(-1)
    best = jnp.argmax(grp_score, axis=-1)
    in_group = (jnp.arange(N_EXPERTS) // EXPERTS_PER_GROUP)[None, :] == best[:, None]
    top_w, top_e = lax.top_k(jnp.where(in_group, scores, -1.0), TOP_K)
    gates = top_w / jnp.sum(top_w, axis=-1, keepdims=True)
    n_assign = T * TOP_K
    flat_e = top_e.reshape(-1)
    flat_tok = jnp.arange(n_assign) // TOP_K
    flat_g = gates.reshape(-1)
    order = jnp.argsort(flat_e)
    sorted_e = flat_e[order]
    counts = jnp.bincount(flat_e, length=N_EXPERTS)
    starts = jnp.cumsum(counts) - counts
    padded = (counts + MOE_BLOCK - 1) // MOE_BLOCK * MOE_BLOCK
    pends = jnp.cumsum(padded)
    pstarts = pends - padded
    dest = pstarts[sorted_e] + (jnp.arange(n_assign) - starts[sorted_e])
    n_rows = n_assign + N_EXPERTS * MOE_BLOCK
    buf_tok = jnp.full((n_rows,), T, dtype=jnp.int32).at[dest].set(flat_tok[order].astype(jnp.int32))
    buf_gate = jnp.zeros((n_rows,), jnp.float32).at[dest].set(flat_g[order])
    n_blocks = n_rows // MOE_BLOCK
    block_e = jnp.clip(jnp.searchsorted(pends, jnp.arange(n_blocks) * MOE_BLOCK, side='right'), 0, N_EXPERTS - 1)
    x_pad = jnp.concatenate([xt, jnp.zeros((1, D), xt.dtype)], axis=0)
    xs = x_pad[buf_tok].reshape(n_blocks, MOE_BLOCK, D)

    def expert_block(args):
        xb, e = args
        hb = jax.nn.silu(xb @ w1[e]) * (xb @ w3[e])
        return hb @ w2[e]

    ys = lax.map(expert_block, (xs, block_e)).reshape(n_rows, D)
    ys = ys * buf_gate[:, None].astype(ys.dtype)
    out = jax.ops.segment_sum(ys, buf_tok, num_segments=T + 1)[:T]
    return out.reshape(Bsz, L, D).astype(x.dtype)


def setup_inputs(seed: int = 0) -> dict:
    key = jax.random.key(seed)
    ks = jax.random.split(key, 32)
    f32 = jnp.float32

    def nrm(k, shape, scale):
        return jax.random.normal(k, shape, f32) * scale

    Lr, D = DEPTH, D_MODEL
    G, P, Cg = S5_GROUPS, S5_STATE, S5_GROUP_CH
    E, F = N_EXPERTS, D_EXPERT
    return {
        'x': nrm(ks[0], (BATCH, SEQ, D), 1.0),
        'ln0_g': 1.0 + nrm(ks[1], (D,), 0.02),
        'ln0_b': nrm(ks[2], (D,), 0.02),
        'w_in': nrm(ks[3], (Lr, D, IN_WIDTH), D ** -0.5),
        's5_lambda_re': -0.5 * (1.0 + nrm(ks[4], (Lr, G, P), 0.02)),
        's5_lambda_im': math.pi * jnp.arange(P, dtype=f32) + nrm(ks[5], (Lr, G, P), 0.02),
        's5_log_dt': jax.random.uniform(ks[6], (Lr, G), f32, math.log(1e-3), math.log(1e-1)),
        's5_b_re': nrm(ks[7], (Lr, G, P, Cg), (2 * Cg) ** -0.5),
        's5_b_im': nrm(ks[8], (Lr, G, P, Cg), (2 * Cg) ** -0.5),
        's5_c_re': nrm(ks[9], (Lr, G, Cg, P), P ** -0.5),
        's5_c_im': nrm(ks[10], (Lr, G, Cg, P), P ** -0.5),
        's5_d': nrm(ks[11], (Lr, S5_WIDTH), 1.0),
        's5_w_glu': nrm(ks[12], (Lr, S5_WIDTH, S5_WIDTH), S5_WIDTH ** -0.5),
        's5_b_glu': nrm(ks[13], (Lr, S5_WIDTH), 0.02),
        'ret_gn_g': 1.0 + nrm(ks[14], (Lr, RET_V_WIDTH), 0.02),
        'w_up_a': nrm(ks[15], (Lr, S5_WIDTH, D), S5_WIDTH ** -0.5),
        'w_up_b': nrm(ks[16], (Lr, SB_WIDTH, D), SB_WIDTH ** -0.5),
        'w_up_c': nrm(ks[17], (Lr, RET_V_WIDTH, D), RET_V_WIDTH ** -0.5),
        'w_out': nrm(ks[18], (Lr, D, D), BETA * D ** -0.5),
        'ln1_g': 1.0 + nrm(ks[19], (Lr, D), 0.02),
        'ln1_b': nrm(ks[20], (Lr, D), 0.02),
        'router_w': nrm(ks[21], (D, E), D ** -0.5),
        'router_b': nrm(ks[22], (E,), 0.01),
        'moe_w1': nrm(ks[23], (Lr, E, D, F), D ** -0.5),
        'moe_w3': nrm(ks[24], (Lr, E, D, F), D ** -0.5),
        'moe_w2': nrm(ks[25], (Lr, E, F, D), BETA * F ** -0.5),
        'ln2_g': 1.0 + nrm(ks[26], (Lr, D), 0.02),
        'ln2_b': nrm(ks[27], (Lr, D), 0.02),
    }


def reference(x, ln0_g, ln0_b, w_in, s5_lambda_re, s5_lambda_im, s5_log_dt, s5_b_re, s5_b_im,
              s5_c_re, s5_c_im, s5_d, s5_w_glu, s5_b_glu, ret_gn_g, w_up_a, w_up_b, w_up_c, w_out,
              ln1_g, ln1_b, router_w, router_b, moe_w1, moe_w3, moe_w2, ln2_g, ln2_b):
    h = layer_norm(x, ln0_g, ln0_b)
    for l in range(DEPTH):
        y = hybrid_mixer(h, w_in[l], s5_lambda_re[l], s5_lambda_im[l], s5_log_dt[l], s5_b_re[l], s5_b_im[l],
                         s5_c_re[l], s5_c_im[l], s5_d[l], s5_w_glu[l], s5_b_glu[l], ret_gn_g[l],
                         w_up_a[l], w_up_b[l], w_up_c[l], w_out[l])
        h = layer_norm(ALPHA * h + y, ln1_g[l], ln1_b[l])
        y = grouped_moe(h, router_w, router_b, moe_w1[l], moe_w3[l], moe_w2[l])
        h = layer_norm(ALPHA * h + y, ln2_g[l], ln2_b[l])
    return h
```

```cpp
#include <hip/hip_runtime.h>
#include <cstdio>
#include <cstdint>
#define DIAG 0
#define N_LAUNCH 1
namespace pg8 {
#define PG8_LAS __attribute__((address_space(3)))
typedef unsigned short bf16_t;
typedef short bf16x8 __attribute__((ext_vector_type(8)));
typedef float f32x4 __attribute__((ext_vector_type(4)));
typedef unsigned u32x4 __attribute__((ext_vector_type(4)));
typedef unsigned u32x2 __attribute__((ext_vector_type(2)));
constexpr int BM = 256, BK = 64, HALF = 128, HTB = HALF * BK * 2, STAGE_BYTES = 8 * HTB, NXCD = 8, WGM = 8;

__host__ __device__ __forceinline__ int lds_byte(int r, int c) { const int st = (r >> 4) * 2 + (c >> 5), rr = r & 15, cc = c & 31, ob = rr * 64 + cc * 2; return st * 1024 + (ob ^ (((ob >> 9) & 1) << 5)); }
__host__ __device__ __forceinline__ void stage_rc(int b, int& R, int& C) { const int st = b / 1024, sb = b % 1024, swz = sb ^ (((sb >> 9) & 1) << 5); R = (st >> 1) * 16 + swz / 64; C = (st & 1) * 32 + (swz % 64) / 2; }
__host__ __device__ __forceinline__ int perm32(int rho) { const int n = rho >> 4, i = rho & 15; return 8 * (i >> 2) + 4 * n + (i & 3); }

struct Unit { int pm, pn, e, pl, cnt; };
struct Gemm { const bf16_t* A; const bf16_t* Bt; int K; };

struct StaticOrder {
    int nM, nN, nwg, G, c;
    __host__ __device__ void init(int M, int N, int G_, int c_) { nM = M / BM; nN = N / BM; nwg = nM * nN; G = G_; c = c_; }
    __host__ __device__ bool next(int i, Unit& u) const {
        const long L = (long)i * G + c; if (L >= nwg) return false;
        int wgid = (int)L; { const int q = nwg / NXCD, r = nwg % NXCD, xcd = wgid % NXCD, off = wgid / NXCD; wgid = (xcd < r ? xcd * (q + 1) : r * (q + 1) + (xcd - r) * q) + off; }
        const int nig = WGM * nN, gid = wgid / nig, fm = gid * WGM, gsz = (nM - fm) < WGM ? (nM - fm) : WGM;
        u.pm = fm + ((wgid % nig) % gsz); u.pn = (wgid % nig) / gsz; u.e = 0; u.pl = 0; u.cnt = 0; return true;
    }
    __device__ __forceinline__ int a_row(const Unit&, int) const { return 0; }
};

__device__ __forceinline__ int launder_i(int x) { asm volatile("" : "+v"(x)); return x; }
__device__ __forceinline__ int lane_id_opaque() { int x; asm volatile("v_mbcnt_lo_u32_b32 %0, -1, 0\n\tv_mbcnt_hi_u32_b32 %0, -1, %0" : "=v"(x)); return x; }
template <class T> __device__ __forceinline__ T* launder_p(T* p) { __attribute__((address_space(1))) T* g = (__attribute__((address_space(1))) T*)p; asm volatile("" : "+s"(g)); return (T*)g; }
__device__ __forceinline__ unsigned cvt_pk_bf16(float lo, float hi) { unsigned r; asm volatile("v_cvt_pk_bf16_f32 %0, %1, %2" : "=v"(r) : "v"(lo), "v"(hi)); return r; }
__device__ __forceinline__ float bf_lo(unsigned w) { return __uint_as_float(w << 16); }
__device__ __forceinline__ float bf_hi(unsigned w) { return __uint_as_float(w & 0xffff0000u); }


template <class Epi, class Sched, bool GATHER = false>
__device__ __forceinline__ void gemm_phase(PG8_LAS unsigned char* lds, const Gemm g, const Sched& S, const Epi& E, const int wave_id) {
    const int lane = lane_id_opaque(), wid = wave_id, tid = wid * 64 + lane, wr = wid >> 2, wc = wid & 3, fr = lane & 15, fq = lane >> 4;
    const int K = g.K, nt = K / BK;
    unsigned voffA[2], voffB[2];
#pragma unroll
    for (int i = 0; i < 2; ++i) { int R, C; stage_rc(tid * 16 + i * 8192, R, C); const int Rb = ((R & ~31) + perm32(R & 31));
        voffA[i] = (unsigned)(R * K + C) * 2u; voffB[i] = (unsigned)(Rb * K + C) * 2u; }
    const size_t kstep = (size_t)(BK * 2);
    const size_t hstep = (size_t)HALF * K * 2;
    const size_t tstep = 2 * hstep;
    const unsigned ldsw = (unsigned)wid * 1024u;
    const int aoff = lds_byte(wr * 64 + fr, fq * 8), boff = lds_byte(wc * 32 + fr, fq * 8);
#define PG8_SA(b, h) (((b) * 2 + (h)) * HTB)
#define PG8_SB(b, h) ((4 + (b) * 2 + (h)) * HTB)
#define PG8_STAGE(bufoff, gbase, voff) do { _Pragma("unroll") for (int _i = 0; _i < 2; ++_i) \
        __builtin_amdgcn_global_load_lds((const unsigned*)((const char*)(gbase) + (voff)[_i]), (PG8_LAS unsigned*)(lds + (bufoff) + ldsw + _i * 8192), 16, 0, 0); } while (0)
#define PG8_STAGE_A(b, h, koff, useN) do { if constexpr (GATHER) { const char* _gb = (const char*)g.A + (koff); PG8_STAGE(PG8_SA(b, h), _gb, voffC[h]); } \
        else { const char* _gb = ((useN) ? nA : cA) + (koff) + (h) * hstep; PG8_STAGE(PG8_SA(b, h), _gb, voffA); } } while (0)
#define PG8_LDA(dst, b, h) do { _Pragma("unroll") for (int m = 0; m < 4; ++m) _Pragma("unroll") for (int k = 0; k < 2; ++k) dst[m][k] = *(const PG8_LAS bf16x8*)(lds + PG8_SA(b, h) + aoff + m * 2048 + k * 1024); } while (0)
#define PG8_LDB(dst, b, h) do { _Pragma("unroll") for (int n = 0; n < 2; ++n) _Pragma("unroll") for (int k = 0; k < 2; ++k) dst[n][k] = *(const PG8_LAS bf16x8*)(lds + PG8_SB(b, h) + boff + n * 2048 + k * 1024); } while (0)
#define PG8_MMA(ai, bj, At, Bt) do { __builtin_amdgcn_s_setprio(1); _Pragma("unroll") for (int m = 0; m < 4; ++m) _Pragma("unroll") for (int n = 0; n < 2; ++n) _Pragma("unroll") for (int k = 0; k < 2; ++k) \
        acc[ai][bj][m][n] = __builtin_amdgcn_mfma_f32_16x16x32_bf16(Bt[n][k], At[m][k], acc[ai][bj][m][n], 0, 0, 0); __builtin_amdgcn_s_setprio(0); } while (0)
#define PG8_WAIT_V(n) asm volatile("s_waitcnt vmcnt(" #n ")" ::: "memory")
#define PG8_WAIT_L(n) asm volatile("s_waitcnt lgkmcnt(" #n ")" ::: "memory")
#define PG8_BAR __builtin_amdgcn_s_barrier()
#define PG8_SCHED __builtin_amdgcn_sched_barrier(0)
    Unit cur, nxt; int ui = 0;
    if (!S.next(0, cur)) return;
    f32x4 acc[2][2][4][2];
#pragma unroll
    for (int a = 0; a < 2; ++a)
#pragma unroll
        for (int b = 0; b < 2; ++b)
#pragma unroll
            for (int m = 0; m < 4; ++m)
#pragma unroll
                for (int n = 0; n < 2; ++n) acc[a][b][m][n] = (f32x4){0.f, 0.f, 0.f, 0.f};
    bf16x8 At[4][2], B0[2][2], B1[2][2];
    const char* cA = (const char*)g.A + (size_t)cur.pm * tstep; const char* cB = (const char*)g.Bt + (size_t)cur.pn * tstep;
    const char* nA = cA;
    unsigned voffC[2][2];
#define PG8_GOFF(unit) do { _Pragma("unroll") for (int h = 0; h < 2; ++h) _Pragma("unroll") for (int i = 0; i < 2; ++i) { int R, C; stage_rc(tid * 16 + i * 8192, R, C); \
        voffC[h][i] = (unsigned)(S.a_row(unit, h * HALF + R) * K + C) * 2u; } } while (0)
    if constexpr (GATHER) PG8_GOFF(cur);
    PG8_STAGE(PG8_SB(0, 0), cB, voffB); PG8_STAGE(PG8_SB(0, 1), cB + hstep, voffB); PG8_STAGE_A(0, 0, 0, false); PG8_STAGE_A(0, 1, 0, false);
    if (wr == 1) PG8_BAR;
    PG8_WAIT_V(2); PG8_BAR;
    PG8_STAGE(PG8_SB(1, 0), cB + kstep, voffB); PG8_STAGE_A(1, 0, kstep, false); PG8_STAGE(PG8_SB(1, 1), cB + hstep + kstep, voffB);
    PG8_WAIT_V(6); PG8_BAR;
    for (;;) {
        const bool has_next = S.next(ui + 1, nxt);
        nA = has_next ? (const char*)g.A + (size_t)nxt.pm * tstep : cA; const char* nB = has_next ? (const char*)g.Bt + (size_t)nxt.pn * tstep : cB;
        for (int t = 0; t < nt; t += 2) {
            const bool last = (t == nt - 2);
            const size_t k1 = (size_t)(t + 1) * kstep;
            const size_t k2 = last ? 0 : (size_t)(t + 2) * kstep, k3 = k2 + kstep;
            const char* b2 = last ? nB : cB + (size_t)(t + 2) * kstep; const char* b3 = b2 + kstep;
            PG8_LDB(B0, 0, 0); PG8_LDB(B1, 0, 1); PG8_SCHED; PG8_LDA(At, 0, 0); PG8_STAGE_A(1, 1, k1, false);
            if constexpr (GATHER) { if (last && has_next) PG8_GOFF(nxt); }
            PG8_WAIT_V(8); PG8_WAIT_L(0); PG8_BAR; PG8_MMA(0, 0, At, B0); PG8_MMA(0, 1, At, B1); PG8_BAR; PG8_SCHED;
            PG8_LDA(At, 0, 1); PG8_STAGE(PG8_SB(0, 0), b2, voffB); PG8_STAGE(PG8_SB(0, 1), b2 + hstep, voffB); PG8_STAGE_A(0, 0, k2, last);
            PG8_WAIT_V(8); PG8_WAIT_L(0); PG8_BAR; PG8_MMA(1, 0, At, B0); PG8_MMA(1, 1, At, B1); PG8_BAR; PG8_SCHED;
            PG8_LDB(B0, 1, 0); PG8_LDB(B1, 1, 1); PG8_SCHED; PG8_LDA(At, 1, 0); PG8_STAGE_A(0, 1, k2, last);
            PG8_WAIT_V(8); PG8_WAIT_L(0); PG8_BAR; PG8_MMA(0, 0, At, B0); PG8_MMA(0, 1, At, B1); PG8_BAR; PG8_SCHED;
            PG8_LDA(At, 1, 1); PG8_STAGE(PG8_SB(1, 0), b3, voffB); PG8_STAGE(PG8_SB(1, 1), b3 + hstep, voffB); PG8_STAGE_A(1, 0, k3, last);
            PG8_WAIT_V(8); PG8_WAIT_L(0); PG8_BAR; PG8_MMA(1, 0, At, B0); PG8_MMA(1, 1, At, B1); PG8_BAR; PG8_SCHED;
        }
        if (wr == 0) PG8_BAR;
        PG8_SCHED; asm volatile("s_nop 15"); PG8_SCHED;
        E(acc, cur, wr, wc, fr, fq);
        if (!has_next) break;
#pragma unroll
        for (int a = 0; a < 2; ++a)
#pragma unroll
            for (int b = 0; b < 2; ++b)
#pragma unroll
                for (int m = 0; m < 4; ++m)
#pragma unroll
                    for (int n = 0; n < 2; ++n) acc[a][b][m][n] = (f32x4){0.f, 0.f, 0.f, 0.f};
        cur = nxt; cA = nA; cB = nB; ++ui;
        if (wr == 1) PG8_BAR;
    }
    PG8_WAIT_V(0);
    PG8_BAR;
#undef PG8_SA
#undef PG8_SB
#undef PG8_STAGE
#undef PG8_STAGE_A
#undef PG8_GOFF
#undef PG8_LDA
#undef PG8_LDB
#undef PG8_MMA
#undef PG8_WAIT_V
#undef PG8_WAIT_L
#undef PG8_BAR
#undef PG8_SCHED
}
}
constexpr int NB = 4, SEQ = 8192, T = NB * SEQ, D = 1024, NCH = SEQ / 64, NLAYER = 2;
constexpr int PW = 2560;
constexpr int C_UA = 0, C_QB = 256, C_KB = 512, C_VB = 768, C_QC = 1024, C_KC = 1280, C_VC = 1536, C_GC = 2048;
constexpr int INW = 5632, NE = 16, FF = 1024;
constexpr float ALPHA = 1.41421356237309515f;
constexpr float LN_EPS = 1e-5f;
constexpr int NWAVES = 8;
constexpr size_t MiB = 1u << 20;
constexpr size_t WS_CTL = 0, CTL_ZERO_BYTES = 1 * MiB;
constexpr size_t WS_ROPE = 1 * MiB;
constexpr size_t WS_S5T = 3 * MiB;
constexpr size_t S5T_BBAR = WS_S5T, S5T_CMAT = WS_S5T + 131072, S5T_LAMC = WS_S5T + 196608, S5T_LAYER = 262144;
constexpr size_t W_IN = 4 * MiB;
constexpr size_t W_UPA = W_IN + 11 * MiB;
constexpr size_t W_UPB = W_UPA + MiB / 2;
constexpr size_t W_UPC = W_UPB + MiB / 2;
constexpr size_t W_OUT = W_UPC + MiB;
constexpr size_t W_GLU = W_OUT + 2 * MiB;
constexpr size_t W_13 = W_GLU + MiB;
constexpr size_t W_2 = W_13 + 64 * MiB;
constexpr size_t WS_H = 116 * MiB;
constexpr size_t WS_R3 = 180 * MiB;
constexpr size_t WS_R4 = 372 * MiB;
constexpr size_t WS_YAP = WS_R4, WS_YA = WS_R4 + 16 * MiB, WS_YB = WS_R4 + 32 * MiB, WS_YC = WS_R4 + 48 * MiB, WS_MRG = WS_R4;
constexpr size_t WS_S5 = 452 * MiB;
constexpr size_t WS_KV = 456 * MiB;
constexpr size_t WS_LIST = 520 * MiB;
constexpr size_t WS_BCNT = 524 * MiB;
constexpr size_t WS_END = 525 * MiB;
static_assert(W_2 + 32 * MiB == WS_H, "weight region");
constexpr int CW_TMO = 0, CW_DIAG = 64, CW_BAR = 4096, CW_CNT = 16384;
constexpr int WAVE_LDS = 18432;
constexpr int MISC_OFF = 8 * WAVE_LDS;
constexpr int LDS_BYTES = MISC_OFF + 8192;

#define GAS __attribute__((address_space(1)))
#define LAS __attribute__((address_space(3)))
typedef unsigned short bf16;
typedef unsigned v4u __attribute__((ext_vector_type(4)));
typedef unsigned v2u __attribute__((ext_vector_type(2)));
typedef float f32x4 __attribute__((ext_vector_type(4)));
typedef float f32x2 __attribute__((ext_vector_type(2)));
typedef short bf16x8 __attribute__((ext_vector_type(8)));
typedef GAS unsigned gu32;
#define RLX_AGENT __ATOMIC_RELAXED, __HIP_MEMORY_SCOPE_AGENT
#define LDS_WAIT() asm volatile("s_waitcnt lgkmcnt(0)" ::: "memory")
#define VM_WAIT() asm volatile("s_waitcnt vmcnt(0)" ::: "memory")
__device__ __forceinline__ unsigned f2bf(float f) { unsigned u = __builtin_bit_cast(unsigned, f); return (u + 0x7fffu + ((u >> 16) & 1u)) >> 16; }
__device__ __forceinline__ unsigned pk2(float lo, float hi) { return f2bf(lo) | (f2bf(hi) << 16); }
__device__ __forceinline__ float bf2f(unsigned b) { return __uint_as_float(b << 16); }
__device__ __forceinline__ float shx(float v, int o, int lane) { return __int_as_float(__builtin_amdgcn_ds_bpermute((lane ^ o) << 2, __float_as_int(v))); }
__device__ __forceinline__ float shup(float v, int d, int lane) { const int src = lane >= d ? lane - d : lane; return __int_as_float(__builtin_amdgcn_ds_bpermute(src << 2, __float_as_int(v))); }
__device__ __forceinline__ float shidx(float v, int src) { return __int_as_float(__builtin_amdgcn_ds_bpermute(src << 2, __float_as_int(v))); }
__device__ __forceinline__ float wave_sum(float v, int lane) {
#pragma unroll
    for (int o = 1; o < 64; o <<= 1) v += shx(v, o, lane);
    return v;
}
__device__ __forceinline__ float sigmoidf_(float x) { return __builtin_amdgcn_rcpf(1.0f + __expf(-x)); }

#define XB_TMO      128
#define XB_XCNT(j)  (256  + 64 * (j))
#define XB_XSUB(j)  (1280 + 64 * (j))
#define XB_XGEN(j)  (2304 + 64 * (j))
#define XB_TOP      3328
#define XB_TOPGEN   3392
#define XCD_BAR_WORDS 3456
#define XB_SPIN_CAP (1u << 18)
__device__ __forceinline__ unsigned xb_ld(unsigned* p)              { return __hip_atomic_load(p, __ATOMIC_RELAXED, __HIP_MEMORY_SCOPE_AGENT); }
__device__ __forceinline__ unsigned xb_add(unsigned* p, unsigned v) { return __hip_atomic_fetch_add(p, v, __ATOMIC_RELAXED, __HIP_MEMORY_SCOPE_AGENT); }
__device__ __forceinline__ unsigned xb_xcc_id() { return (unsigned)__builtin_amdgcn_s_getreg((3 << 11) | 20) & 0xFu; }
#define XB_SPIN(cond, bar) do { unsigned _sp = 0; while (cond) { __builtin_amdgcn_s_sleep(1); \
    if ((++_sp & 255u) == 0u) { if (xb_ld(&(bar)[XB_TMO])) break; if (_sp > XB_SPIN_CAP) { atomicAdd(&(bar)[XB_TMO], 1u); break; } } } } while (0)
struct XcdBarrier { unsigned* bar; unsigned x; volatile LAS unsigned* st; };
__device__ __forceinline__ XcdBarrier xcd_barrier_post(unsigned* bar, volatile LAS unsigned* st) {
    XcdBarrier b; b.bar = bar; b.x = xb_xcc_id(); b.st = st;
    if (threadIdx.x == 0) (void)xb_add(&bar[XB_XCNT(b.x)], 1u);
    return b;
}
__device__ __forceinline__ void xcd_barrier_complete(unsigned* bar, unsigned x, unsigned& nloc, unsigned& nx) {
    const unsigned G = gridDim.x * gridDim.y * gridDim.z;
    unsigned sum, cnt, mine, sp = 0u;
    for (;;) {
        sum = 0u; cnt = 0u; mine = 0u;
#pragma unroll
        for (unsigned j = 0; j < 16; ++j) { const unsigned c = xb_ld(&bar[XB_XCNT(j)]); sum += c; cnt += (c > 0u) ? 1u : 0u; mine = (j == x) ? c : mine; }
        if (sum == G) break;
        __builtin_amdgcn_s_sleep(1);
        if ((++sp & 255u) == 0u) { if (xb_ld(&bar[XB_TMO])) break; if (sp > XB_SPIN_CAP) { atomicAdd(&bar[XB_TMO], 1u); break; } }
    }
    nloc = mine > 0u ? mine : 1u; nx = cnt > 0u ? cnt : 1u;
}
__device__ __forceinline__ void xcd_barrier(const XcdBarrier& b) {
    asm volatile("s_waitcnt vmcnt(0)" ::: "memory");
    __syncthreads();
    if (threadIdx.x == 0) {
        unsigned* bar = b.bar;
        __builtin_amdgcn_s_waitcnt(0);
        unsigned nloc = b.st[0], nx = b.st[1];
        if (nloc == 0u) { xcd_barrier_complete(bar, b.x, nloc, nx); b.st[0] = nloc; b.st[1] = nx; }
        const unsigned old = xb_add(&bar[XB_XSUB(b.x)], 1u);
        const unsigned gen = old / nloc;
        if (old + 1u == (gen + 1u) * nloc) {
            __builtin_amdgcn_fence(__ATOMIC_RELEASE, "agent");
            asm volatile("s_waitcnt vmcnt(0)" ::: "memory");
            const unsigned og = xb_add(&bar[XB_TOP], 1u);
            const unsigned tg = og / nx;
            if (og + 1u == (tg + 1u) * nx) xb_add(&bar[XB_TOPGEN], 1u);
            else XB_SPIN(xb_ld(&bar[XB_TOPGEN]) == tg, bar);
            __builtin_amdgcn_fence(__ATOMIC_ACQUIRE, "agent");
            xb_add(&bar[XB_XGEN(b.x)], 1u);
            asm volatile("s_waitcnt vmcnt(0)" ::: "memory");
        } else {
            XB_SPIN(xb_ld(&bar[XB_XGEN(b.x)]) == gen, bar);
            __builtin_amdgcn_fence(__ATOMIC_ACQUIRE, "agent");
            asm volatile("s_waitcnt vmcnt(0)" ::: "memory");
        }
    }
    __syncthreads();
}

struct Frame {
    LAS unsigned char* lds;
    volatile LAS unsigned* MISC;
    gu32* ctl;
    unsigned char* ws;
    int tid, lane, wave, vcu, G, gw, NGW;
    const __attribute__((address_space(4))) char* ka; float* out;
};
#define FIN(i) ((const float*)(const __attribute__((address_space(1))) float*)(*(const float* const volatile __attribute__((address_space(4)))*)(F.ka + 8 * (i))))
__device__ __forceinline__ void p0_transpose_item(const float* W, int K, int N, bf16* WT, int row_off, LAS float* scr, int item, int lane) {
    const int nblk = N / 32, kb = item / nblk, nb = item % nblk, k0 = 64 * kb, n0 = 32 * nb;
#pragma unroll 8
    for (int i = 0; i < 32; ++i) { const int kk = 2 * i + (lane >> 5); scr[kk * 33 + (lane & 31)] = W[(size_t)(k0 + kk) * N + n0 + (lane & 31)]; }
    LDS_WAIT(); asm volatile("" ::: "memory");
    const int c = lane & 7;
#pragma unroll
    for (int j = 0; j < 4; ++j) { const int n = (lane >> 3) + 8 * j; const LAS float* s = scr + (8 * c) * 33 + n;
        v4u o; o.x = pk2(s[0 * 33], s[1 * 33]); o.y = pk2(s[2 * 33], s[3 * 33]); o.z = pk2(s[4 * 33], s[5 * 33]); o.w = pk2(s[6 * 33], s[7 * 33]);
        *(GAS v4u*)(WT + (size_t)(row_off + n0 + n) * K + k0 + 8 * c) = o; }
    LDS_WAIT(); asm volatile("" ::: "memory");
}
__device__ __forceinline__ void ln_row(f32x4 (&v)[4], const float* g, const float* b, int lane) {
    float s = 0.f;
#pragma unroll
    for (int j = 0; j < 4; ++j) s += (v[j].x + v[j].y) + (v[j].z + v[j].w);
    const float mean = wave_sum(s, lane) * (1.f / D); float s2 = 0.f;
#pragma unroll
    for (int j = 0; j < 4; ++j) { v[j] = v[j] - mean; s2 += (v[j].x * v[j].x + v[j].y * v[j].y) + (v[j].z * v[j].z + v[j].w * v[j].w); }
    const float rstd = 1.f / sqrtf(wave_sum(s2, lane) * (1.f / D) + LN_EPS);
#pragma unroll
    for (int j = 0; j < 4; ++j) { const f32x4 gg = *(const f32x4*)(g + 4 * lane + 256 * j), bb = *(const f32x4*)(b + 4 * lane + 256 * j); v[j] = v[j] * rstd * gg + bb; }
}
__device__ __forceinline__ void store_row_bf16(const f32x4 (&v)[4], bf16* orow, int lane) {
    GAS unsigned long long* o8 = (GAS unsigned long long*)orow + lane;
#pragma unroll
    for (int j = 0; j < 4; ++j) o8[64 * j] = (unsigned long long)pk2(v[j].x, v[j].y) | ((unsigned long long)pk2(v[j].z, v[j].w) << 32);
}
__device__ __forceinline__ void load_row_bf16(f32x4 (&v)[4], const bf16* irow, int lane) {
    const GAS unsigned long long* i8 = (const GAS unsigned long long*)irow + lane;
#pragma unroll
    for (int j = 0; j < 4; ++j) { const unsigned long long w = i8[64 * j]; const unsigned lo = (unsigned)w, hi = (unsigned)(w >> 32);
        v[j] = (f32x4){bf2f(lo & 0xffffu), bf2f(lo >> 16), bf2f(hi & 0xffffu), bf2f(hi >> 16)}; }
}

__device__ __forceinline__ void conv_weights(Frame& F, int l) {
    const float* in3 = FIN(3); const float* in12 = FIN(12); const float* in15 = FIN(15); const float* in16 = FIN(16); const float* in17 = FIN(17); const float* in18 = FIN(18); const float* in23 = FIN(23); const float* in24 = FIN(24); const float* in25 = FIN(25);
    LAS float* scr = (LAS float*)(F.lds + F.wave * WAVE_LDS);
    constexpr int I_IN = 16 * 176, I_UA = 4 * 32, I_UC = 8 * 32, I_OUT = 16 * 32, I_GLU = 4 * 8, I_E = 16 * 32;
    constexpr int NITEMS = I_IN + 2 * I_UA + I_UC + I_OUT + I_GLU + 3 * NE * I_E;
    unsigned char* ws = F.ws;
    for (int it = F.gw; it < NITEMS; it += F.NGW) {
        int r = it; const float* W; bf16* WT; int K, N, row_off = 0;
        if (r < I_IN) { W = in3 + (size_t)l * D * INW; K = D; N = INW; WT = (bf16*)(ws + W_IN); }
        else if ((r -= I_IN) < I_UA) { W = in15 + (size_t)l * 256 * D; K = 256; N = D; WT = (bf16*)(ws + W_UPA); }
        else if ((r -= I_UA) < I_UA) { W = in16 + (size_t)l * 256 * D; K = 256; N = D; WT = (bf16*)(ws + W_UPB); }
        else if ((r -= I_UA) < I_UC) { W = in17 + (size_t)l * 512 * D; K = 512; N = D; WT = (bf16*)(ws + W_UPC); }
        else if ((r -= I_UC) < I_OUT) { W = in18 + (size_t)l * D * D; K = D; N = D; WT = (bf16*)(ws + W_OUT); }
        else if ((r -= I_OUT) < I_GLU) { W = in12 + (size_t)l * 256 * 256; K = 256; N = 256; WT = (bf16*)(ws + W_GLU); }
        else { r -= I_GLU; const int which = r / (NE * I_E); r -= which * (NE * I_E); const int e = r / I_E; r -= e * I_E; K = D; N = FF;
            if (which < 2) {
                const int n0 = 32 * (r % 32); row_off = e * 2048 + (n0 / 128) * 256 + (n0 % 128) + which * 128 - n0;
                W = (which == 0 ? in23 : in24) + ((size_t)l * NE + e) * D * FF; WT = (bf16*)(ws + W_13);
            } else { W = in25 + ((size_t)l * NE + e) * FF * D; WT = (bf16*)(ws + W_2); row_off = e * 1024; }
        }
        p0_transpose_item(W, K, N, WT, row_off, scr, r, pg8::launder_i(F.lane));
    }
}
__device__ __forceinline__ void s5_tables(Frame& F, int l) {
    const float* in4 = FIN(4); const float* in5 = FIN(5); const float* in6 = FIN(6); const float* in7 = FIN(7); const float* in8 = FIN(8); const float* in9 = FIN(9); const float* in10 = FIN(10);
    const int gt = blockIdx.x * (NWAVES * 64) + F.tid;
    if (gt < 1024) {
        const int g = gt >> 6, p = gt & 63;
        const double dt = exp((double)in6[l * 16 + g]);
        const double lre = (double)in4[l * 1024 + gt], lim = (double)in5[l * 1024 + gt];
        const double er = exp(lre * dt), lbr = er * cos(lim * dt), lbi = er * sin(lim * dt);
        const double nr = lbr - 1.0, ni = lbi, den = lre * lre + lim * lim;
        const double zr = (nr * lre + ni * lim) / den, zi = (ni * lre - nr * lim) / den;
        bf16* bbar = (bf16*)(F.ws + S5T_BBAR + (size_t)l * S5T_LAYER) + (size_t)g * 128 * 32;
        bf16* cmat = (bf16*)(F.ws + S5T_CMAT + (size_t)l * S5T_LAYER) + (size_t)g * 16 * 128;
        f32x2* lamc = (f32x2*)(F.ws + S5T_LAMC + (size_t)l * S5T_LAYER) + (size_t)gt * 8;
        const int nre = 32 * (p >> 4) + (p & 15), nim = nre + 16;
        const float* bre = in7 + ((size_t)l * 1024 + gt) * 16; const float* bim = in8 + ((size_t)l * 1024 + gt) * 16;
        for (int c = 0; c < 16; ++c) { const double br = bre[c], bi = bim[c];
            bbar[nre * 32 + c] = (bf16)f2bf((float)(br * zr - bi * zi)); bbar[nim * 32 + c] = (bf16)f2bf((float)(br * zi + bi * zr));
            bbar[nre * 32 + 16 + c] = 0; bbar[nim * 32 + 16 + c] = 0; }
        const float* cre = in9 + ((size_t)l * 16 + g) * 16 * 64; const float* cim = in10 + ((size_t)l * 16 + g) * 16 * 64;
        for (int c = 0; c < 16; ++c) { cmat[c * 128 + nre] = (bf16)f2bf(cre[c * 64 + p]); cmat[c * 128 + nim] = (bf16)f2bf(-cim[c * 64 + p]); }
        const int pw[8] = {1, 2, 3, 4, 8, 12, 16, 64};
#pragma unroll
        for (int j = 0; j < 8; ++j) { const double k = (double)pw[j], e = exp(k * lre * dt); lamc[j] = (f32x2){(float)(e * cos(k * lim * dt)), (float)(e * sin(k * lim * dt))}; }
    }
}
__device__ __forceinline__ void rope_table(Frame& F) {
    f32x2* tab = (f32x2*)(F.ws + WS_ROPE);
    const int nthr = F.G * NWAVES * 64;
    for (int i = blockIdx.x * (NWAVES * 64) + F.tid; i < SEQ * 32; i += nthr) {
        const int pos = i >> 5, fi = i & 31;
        const double a = (double)pos * pow(10000.0, -(double)fi / 32.0);
        tab[i] = (f32x2){(float)cos(a), (float)sin(a)};
    }
}
__device__ __forceinline__ void ln0_phase(Frame& F) {
    const float* in0 = FIN(0); const float* in1 = FIN(1); const float* in2 = FIN(2);
    bf16* H = (bf16*)(F.ws + WS_H);
    for (int m = F.gw; m < T; m += F.NGW) {
        const GAS f32x4* xr = (const GAS f32x4*)(in0 + (size_t)m * D) + F.lane;
        f32x4 v[4];
#pragma unroll
        for (int j = 0; j < 4; ++j) v[j] = xr[64 * j];
        ln_row(v, in1, in2, F.lane);
        store_row_bf16(v, H + (size_t)m * D, F.lane);
    }
}
namespace pg8 {
struct EpiStore {
    bf16_t* O; int ldc;
    __device__ __forceinline__ void operator()(const f32x4 (&acc)[2][2][4][2], const Unit& u, int wr, int wc, int fr_, int fq_) const {
        const int fr = launder_i(fr_), fq = launder_i(fq_);
        const int row0 = u.pm * BM + wr * 64 + fr, col0 = u.pn * BM + wc * 32 + 8 * fq;
#pragma unroll
        for (int ai = 0; ai < 2; ++ai)
#pragma unroll
            for (int m = 0; m < 4; ++m) { bf16_t* rowp = O + (size_t)(row0 + ai * HALF + m * 16) * ldc + col0;
#pragma unroll
                for (int bj = 0; bj < 2; ++bj) { const f32x4 v0 = acc[ai][bj][m][0], v1 = acc[ai][bj][m][1];
                    u32x4 w; w.x = cvt_pk_bf16(v0[0], v0[1]); w.y = cvt_pk_bf16(v0[2], v0[3]); w.z = cvt_pk_bf16(v1[0], v1[1]); w.w = cvt_pk_bf16(v1[2], v1[3]);
                    *(u32x4*)(rowp + bj * HALF) = w; } }
    }
};
struct EpiGlu {
    const bf16_t* Y; bf16_t* O; const float* bias;
    __device__ __forceinline__ void operator()(const f32x4 (&acc)[2][2][4][2], const Unit& u, int wr, int wc, int fr_, int fq_) const {
        const int fr = launder_i(fr_), fq = launder_i(fq_);
        const int row0 = u.pm * BM + wr * 64 + fr, col0 = wc * 32 + 8 * fq;
#pragma unroll
        for (int ai = 0; ai < 2; ++ai)
#pragma unroll
            for (int m = 0; m < 4; ++m) { const size_t off = (size_t)(row0 + ai * HALF + m * 16) * 256 + col0;
#pragma unroll
                for (int bj = 0; bj < 2; ++bj) { const u32x4 yw = *(const u32x4*)(Y + off + bj * HALF);
                    const f32x4 a0 = acc[ai][bj][m][0] + *(const f32x4*)(bias + col0 + bj * HALF), a1 = acc[ai][bj][m][1] + *(const f32x4*)(bias + col0 + bj * HALF + 4);
                    const float y0 = bf_lo(yw.x), y1 = bf_hi(yw.x), y2 = bf_lo(yw.y), y3 = bf_hi(yw.y), y4 = bf_lo(yw.z), y5 = bf_hi(yw.z), y6 = bf_lo(yw.w), y7 = bf_hi(yw.w);
                    u32x4 w; w.x = cvt_pk_bf16(y0 * sigmoidf_(a0[0]), y1 * sigmoidf_(a0[1])); w.y = cvt_pk_bf16(y2 * sigmoidf_(a0[2]), y3 * sigmoidf_(a0[3]));
                    w.z = cvt_pk_bf16(y4 * sigmoidf_(a1[0]), y5 * sigmoidf_(a1[1])); w.w = cvt_pk_bf16(y6 * sigmoidf_(a1[2]), y7 * sigmoidf_(a1[3]));
                    *(u32x4*)(O + off + bj * HALF) = w; }
                asm volatile("" ::: "memory"); }
    }
};
struct EpiGate {
    const bf16_t* U; float* P32; bf16_t* MRG;
    __device__ __forceinline__ void operator()(const f32x4 (&acc)[2][2][4][2], const Unit& u, int wr, int wc, int fr_, int fq_) const {
        const int fr = launder_i(fr_), fq = launder_i(fq_);
        const int br = u.pn >> 2, pc = u.pn & 3;
        const int row0 = u.pm * BM + wr * 64 + fr, col0 = pc * BM + wc * 32 + 8 * fq;
#pragma unroll
        for (int ai = 0; ai < 2; ++ai)
#pragma unroll
            for (int m = 0; m < 4; ++m) { const size_t r = (size_t)(row0 + ai * HALF + m * 16);
#pragma unroll
                for (int bj = 0; bj < 2; ++bj) { const int c = col0 + bj * HALF;
                    const u32x4 uw = *(const u32x4*)(U + r * 3072 + br * 1024 + c);
                    const f32x4 a0 = acc[ai][bj][m][0], a1 = acc[ai][bj][m][1];
                    f32x4 p0, p1;
                    p0[0] = sigmoidf_(a0[0]) * bf_lo(uw.x); p0[1] = sigmoidf_(a0[1]) * bf_hi(uw.x); p0[2] = sigmoidf_(a0[2]) * bf_lo(uw.y); p0[3] = sigmoidf_(a0[3]) * bf_hi(uw.y);
                    p1[0] = sigmoidf_(a1[0]) * bf_lo(uw.z); p1[1] = sigmoidf_(a1[1]) * bf_hi(uw.z); p1[2] = sigmoidf_(a1[2]) * bf_lo(uw.w); p1[3] = sigmoidf_(a1[3]) * bf_hi(uw.w);
                    float* pp = P32 + r * 1024 + c;
                    if (br > 0) { p0 += *(const f32x4*)pp; p1 += *(const f32x4*)(pp + 4); }
                    if (br < 2) { *(f32x4*)pp = p0; *(f32x4*)(pp + 4) = p1; }
                    else { u32x4 w; w.x = cvt_pk_bf16(p0[0], p0[1]); w.y = cvt_pk_bf16(p0[2], p0[3]); w.z = cvt_pk_bf16(p1[0], p1[1]); w.w = cvt_pk_bf16(p1[2], p1[3]);
                        *(u32x4*)(MRG + r * 1024 + c) = w; } }
                asm volatile("" ::: "memory"); }
    }
};
struct GateOrder {
    int G, vc;
    __device__ __forceinline__ bool next(int i, Unit& u) const {
        const int tr = i / 3, br = i - 3 * tr; const int L = tr * G + vc; if (L >= (T / BM) * 4) return false;
        u.pm = L >> 2; u.pn = br * 4 + (L & 3); u.e = 0; u.pl = 0; u.cnt = 0; return true;
    }
    __device__ __forceinline__ int a_row(const Unit&, int) const { return 0; }
};
struct EpiOut {
    const bf16_t* Hh; bf16_t* Z;
    __device__ __forceinline__ void operator()(const f32x4 (&acc)[2][2][4][2], const Unit& u, int wr, int wc, int fr_, int fq_) const {
        const int fr = launder_i(fr_), fq = launder_i(fq_);
        const int row0 = u.pm * BM + wr * 64 + fr, col0 = u.pn * BM + wc * 32 + 8 * fq;
#pragma unroll
        for (int ai = 0; ai < 2; ++ai)
#pragma unroll
            for (int m = 0; m < 4; ++m) { const size_t off = (size_t)(row0 + ai * HALF + m * 16) * 1024 + col0;
#pragma unroll
                for (int bj = 0; bj < 2; ++bj) { const u32x4 hw = *(const u32x4*)(Hh + off + bj * HALF);
                    const f32x4 a0 = acc[ai][bj][m][0], a1 = acc[ai][bj][m][1];
                    u32x4 w; w.x = cvt_pk_bf16(ALPHA * bf_lo(hw.x) + a0[0], ALPHA * bf_hi(hw.x) + a0[1]); w.y = cvt_pk_bf16(ALPHA * bf_lo(hw.y) + a0[2], ALPHA * bf_hi(hw.y) + a0[3]);
                    w.z = cvt_pk_bf16(ALPHA * bf_lo(hw.z) + a1[0], ALPHA * bf_hi(hw.z) + a1[1]); w.w = cvt_pk_bf16(ALPHA * bf_lo(hw.w) + a1[2], ALPHA * bf_hi(hw.w) + a1[3]);
                    *(u32x4*)(Z + off + bj * HALF) = w; }
                asm volatile("" ::: "memory"); }
    }
};
struct MoeOrder {
    volatile PG8_LAS int* tab; const int* list; int NT, G, vc, NP;
    __device__ __forceinline__ bool next(int i, Unit& u) const {
        const int L = i * G + vc; if (L >= NP * NT) return false;
        const int p = L / NT, ct = L - p * NT; int e = 0;
        for (int j = 1; j < 16; ++j) e = (p >= tab[16 + j]) ? j : e;
        u.pm = p; u.e = e; u.pl = p - tab[16 + e]; u.cnt = tab[e]; u.pn = e * NT + ct; return true;
    }
    __device__ __forceinline__ int a_row(const Unit& u, int r) const { const int idx = u.pl * BM + r; return idx < u.cnt ? (list[(size_t)u.e * T + idx] >> 1) : 0; }
};
struct EpiFfn1 {
    bf16_t* HB;
    __device__ __forceinline__ void operator()(const f32x4 (&acc)[2][2][4][2], const Unit& u, int wr, int wc, int fr_, int fq_) const {
        const int fr = launder_i(fr_), fq = launder_i(fq_);
        const int ct = u.pn & 7; const int row0 = u.pm * BM + wr * 64 + fr, col0 = ct * HALF + wc * 32 + 8 * fq;
#pragma unroll
        for (int ai = 0; ai < 2; ++ai)
#pragma unroll
            for (int m = 0; m < 4; ++m) { bf16_t* rowp = HB + (size_t)(row0 + ai * HALF + m * 16) * FF + col0;
                float h[8];
#pragma unroll
                for (int n = 0; n < 2; ++n)
#pragma unroll
                    for (int j = 0; j < 4; ++j) { const float a = acc[ai][0][m][n][j], b = acc[ai][1][m][n][j]; h[4 * n + j] = a * sigmoidf_(a) * b; }
                u32x4 w; w.x = cvt_pk_bf16(h[0], h[1]); w.y = cvt_pk_bf16(h[2], h[3]); w.z = cvt_pk_bf16(h[4], h[5]); w.w = cvt_pk_bf16(h[6], h[7]);
                *(u32x4*)rowp = w; }
    }
};
struct EpiFfn2 {
    const int* list; const float* lgate; bf16_t* YS;
    __device__ __forceinline__ void operator()(const f32x4 (&acc)[2][2][4][2], const Unit& u, int wr, int wc, int fr_, int fq_) const {
        const int fr = launder_i(fr_), fq = launder_i(fq_);
        const int ct = u.pn & 3; const int col0 = ct * BM + wc * 32 + 8 * fq;
#pragma unroll
        for (int ai = 0; ai < 2; ++ai)
#pragma unroll
            for (int m = 0; m < 4; ++m) { const int idx = u.pl * BM + ai * HALF + wr * 64 + m * 16 + fr;
                if (idx < u.cnt) { const int entry = list[(size_t)u.e * T + idx]; const float gt = lgate[(size_t)u.e * T + idx];
                    bf16_t* rowp = YS + (size_t)entry * 1024 + col0;
#pragma unroll
                    for (int bj = 0; bj < 2; ++bj) { const f32x4 v0 = acc[ai][bj][m][0] * gt, v1 = acc[ai][bj][m][1] * gt;
                        u32x4 w; w.x = cvt_pk_bf16(v0[0], v0[1]); w.y = cvt_pk_bf16(v0[2], v0[3]); w.z = cvt_pk_bf16(v1[0], v1[1]); w.w = cvt_pk_bf16(v1[2], v1[3]);
                        *(u32x4*)(rowp + bj * HALF) = w; } }
                asm volatile("" ::: "memory"); }
    }
};
}
__device__ __forceinline__ void ln1_route_phase(Frame& F, int l) {
    const float* in19 = FIN(19); const float* in20 = FIN(20); const float* in21 = FIN(21); const float* in22 = FIN(22);
    const bf16* Z = (const bf16*)(F.ws + WS_R3); bf16* H = (bf16*)(F.ws + WS_H);
    int* bcnt = (int*)(F.ws + WS_BCNT);
    LAS float* rwT = (LAS float*)F.lds;
    LAS int* sel_e = (LAS int*)(F.lds + 65536); LAS float* sel_g = (LAS float*)(F.lds + 65536 + 1024); LAS int* rnk = (LAS int*)(F.lds + 65536 + 2048);
    for (int i = F.tid; i < 16 * 1024; i += NWAVES * 64) { const int k = i >> 4, e = i & 15; rwT[e * 1024 + k] = in21[i]; }
    __syncthreads();
    const float* g1 = in19 + (size_t)l * D; const float* b1 = in20 + (size_t)l * D;
    for (int rb = blockIdx.x; rb < T / 128; rb += F.G) {
        for (int i = 0; i < 16; ++i) {
            const int tl = F.wave * 16 + i, m = rb * 128 + tl;
            f32x4 v[4];
            load_row_bf16(v, Z + (size_t)m * D, F.lane);
            ln_row(v, g1, b1, F.lane);
            store_row_bf16(v, H + (size_t)m * D, F.lane);
            float lg[16];
#pragma unroll
            for (int e = 0; e < 16; ++e) { float s = 0.f;
#pragma unroll
                for (int j = 0; j < 4; ++j) { const f32x4 w = *(const LAS f32x4*)(rwT + e * 1024 + 4 * F.lane + 256 * j); s += (v[j].x * w.x + v[j].y * w.y) + (v[j].z * w.z + v[j].w * w.w); }
                lg[e] = wave_sum(s, F.lane) + in22[e]; }
#if DIAG == 11
            { float* orow = F.out + (size_t)m * D;
              for (int c = F.lane; c < 1024; c += 64) orow[c] = 0.f;
#pragma unroll
              for (int e = 0; e < 16; ++e) if (F.lane == e) { const float x = lg[e] * 4096.0f; orow[e] = x - floorf(x); }
              if (F.lane == 20) { const float x = v[0].x * 65536.0f; orow[20] = x - floorf(x); } }
#endif
            float mx = lg[0];
#pragma unroll
            for (int e = 1; e < 16; ++e) mx = fmaxf(mx, lg[e]);
            float sum = 0.f;
#pragma unroll
            for (int e = 0; e < 16; ++e) { lg[e] = __expf(lg[e] - mx); sum += lg[e]; }
            const float inv = 1.0f / sum;
#pragma unroll
            for (int e = 0; e < 16; ++e) lg[e] *= inv;
            float gs[4];
#pragma unroll
            for (int q = 0; q < 4; ++q) { const float a = lg[4 * q], b = lg[4 * q + 1], c = lg[4 * q + 2], d = lg[4 * q + 3];
                const float h1 = fmaxf(a, b), l1 = fminf(a, b), h2 = fmaxf(c, d), l2 = fminf(c, d);
                gs[q] = fmaxf(h1, h2) + fmaxf(fminf(h1, h2), fmaxf(l1, l2)); }
            int best = 0; float bv = gs[0];
#pragma unroll
            for (int q = 1; q < 4; ++q) if (gs[q] > bv) { bv = gs[q]; best = q; }
            float s4[4];
#pragma unroll
            for (int j = 0; j < 4; ++j) s4[j] = best == 0 ? lg[j] : best == 1 ? lg[4 + j] : best == 2 ? lg[8 + j] : lg[12 + j];
            int i1 = 0; float v1 = s4[0];
#pragma unroll
            for (int j = 1; j < 4; ++j) if (s4[j] > v1) { v1 = s4[j]; i1 = j; }
            int i2 = -1; float v2 = -1.f;
#pragma unroll
            for (int j = 0; j < 4; ++j) if (j != i1 && s4[j] > v2) { v2 = s4[j]; i2 = j; }
            if (F.lane == 0) { const float den = v1 + v2;
                sel_e[2 * tl] = 4 * best + i1; sel_e[2 * tl + 1] = 4 * best + i2; sel_g[2 * tl] = v1 / den; sel_g[2 * tl + 1] = v2 / den; }
        }
        __syncthreads();
        if (F.tid < 16) { int c = 0; for (int a = 0; a < 256; ++a) if (sel_e[a] == F.tid) { rnk[a] = c; ++c; }
            bcnt[rb * 16 + F.tid] = c; }
        __syncthreads();
    }
}
__device__ __forceinline__ void dispatch_phase(Frame& F) {
    int* list = (int*)(F.ws + WS_LIST); float* lgate = (float*)(F.ws + WS_LIST + 2 * MiB); const int* bcnt = (const int*)(F.ws + WS_BCNT);
    LAS int* sel_e = (LAS int*)(F.lds + 65536); LAS float* sel_g = (LAS float*)(F.lds + 65536 + 1024); LAS int* rnk = (LAS int*)(F.lds + 65536 + 2048); LAS int* ebase = (LAS int*)(F.lds + 65536 + 3072);
    const int rb = blockIdx.x;
    if (F.tid < 16) { int b = 0; for (int j = 0; j < rb; ++j) b += bcnt[j * 16 + F.tid]; ebase[F.tid] = b; }
    __syncthreads();
    if (F.tid < 256) { const int a = F.tid, e = sel_e[a], pos = ebase[e] + rnk[a];
        list[(size_t)e * T + pos] = 2 * (rb * 128 + (a >> 1)) + (a & 1); lgate[(size_t)e * T + pos] = sel_g[a]; }
    __syncthreads();
}
__device__ __forceinline__ int moe_table(Frame& F, volatile LAS int* tab) {
    const int* bcnt = (const int*)(F.ws + WS_BCNT);
    if (F.tid < 16) { int c = 0; for (int j = 0; j < T / 128; ++j) c += bcnt[j * 16 + F.tid]; tab[F.tid] = c; }
    __syncthreads();
    if (F.tid == 0) { int ps = 0; for (int e = 0; e < 16; ++e) { tab[16 + e] = ps; ps += (tab[e] + 255) >> 8; } tab[32] = ps; }
    __syncthreads();
    return tab[32];
}
__device__ __forceinline__ void ln2_phase(Frame& F, int l, bool last) {
    const float* in26 = FIN(26); const float* in27 = FIN(27);
    bf16* H = (bf16*)(F.ws + WS_H); const bf16* YS = (const bf16*)F.out;
    const float* g2 = in26 + (size_t)l * D; const float* b2 = in27 + (size_t)l * D;
    for (int m = F.gw; m < T; m += F.NGW) {
        f32x4 v[4], a[4], b[4];
        load_row_bf16(v, H + (size_t)m * D, F.lane); load_row_bf16(a, YS + (size_t)(2 * m) * D, F.lane); load_row_bf16(b, YS + (size_t)(2 * m + 1) * D, F.lane);
#pragma unroll
        for (int j = 0; j < 4; ++j) v[j] = v[j] * ALPHA + (a[j] + b[j]);
        ln_row(v, g2, b2, F.lane);
        if (last) { GAS f32x4* o = (GAS f32x4*)(F.out + (size_t)m * D) + F.lane;
#pragma unroll
            for (int j = 0; j < 4; ++j) o[64 * j] = v[j]; }
        else store_row_bf16(v, H + (size_t)m * D, F.lane);
    }
}
#define MFMA16(a, b, c) __builtin_amdgcn_mfma_f32_16x16x32_bf16((a), (b), (c), 0, 0, 0)
#define SB0() __builtin_amdgcn_sched_barrier(0)
#define SETTLE1(a) asm volatile("s_nop 15" : "+v"(a))
#define SETTLE2(a, b) asm volatile("s_nop 15" : "+v"(a), "+v"(b))
#define SETTLE4(a, b, c, d) asm volatile("s_nop 15" : "+v"(a), "+v"(b), "+v"(c), "+v"(d))
__device__ __forceinline__ unsigned long long pack4(float a, float b, float c, float d) { return (unsigned long long)pk2(a, b) | ((unsigned long long)pk2(c, d) << 32); SB0(); }
__device__ __forceinline__ float gamma_log2(int h) { return __log2f(1.0f - exp2f(-5.0f - (float)h)); }
union BF8 { bf16x8 v; v4u u; unsigned short s[8]; };

__device__ __forceinline__ void sb_phase(Frame& F) {
    const bf16* P = (const bf16*)(F.ws + WS_R3); bf16* YB = (bf16*)(F.ws + WS_YB);
    LAS bf16* VT = (LAS bf16*)(F.lds + F.wave * WAVE_LDS);
    LAS bf16* Wt = VT + 64 * 40;
    const int lane = pg8::launder_i(F.lane), fr = lane & 15, q = lane >> 4;
    for (int u = F.gw; u < NB * 4 * 512; u += F.NGW) {
        const int qt = u & 511, h = (u >> 9) & 3, b = u >> 11;
        const int t0 = qt * 16, tq = t0 + fr; const size_t rowbase = (size_t)b * SEQ;
        const bf16* qp = P + (rowbase + tq) * PW + C_QB + h * 64 + 8 * q;
        const bf16x8 bq0 = *(const bf16x8*)qp, bq1 = *(const bf16x8*)(qp + 32);
        f32x4 o[4];
#pragma unroll
        for (int i = 0; i < 4; ++i) o[i] = (f32x4){0.f, 0.f, 0.f, 0.f};
        float carry = 0.f;
        for (int jb = t0 >> 5; jb >= 0; --jb) {
            const int kb = jb * 32;
            f32x4 z[2];
            SB0();
#pragma unroll
            for (int i = 0; i < 2; ++i) { const bf16* kp = P + (rowbase + kb + 16 * i + fr) * PW + C_KB + h * 64 + 8 * q;
                const bf16x8 a0 = *(const bf16x8*)kp, a1 = *(const bf16x8*)(kp + 32);
                z[i] = MFMA16(a0, bq0, ((f32x4){0.f, 0.f, 0.f, 0.f})); z[i] = MFMA16(a1, bq1, z[i]); }
            SETTLE2(z[0], z[1]); SB0();
            BF8 vv[4];
#pragma unroll
            for (int pp = 0; pp < 4; ++pp) { const int idx = lane + 64 * pp, key = idx >> 3, dc = idx & 7;
                vv[pp].u = *(const v4u*)(P + (rowbase + kb + key) * PW + C_VB + h * 64 + dc * 8); }
            float lb[2][4], lz[2][4], tot[2];
#pragma unroll
            for (int i = 0; i < 2; ++i) { tot[i] = 0.f;
#pragma unroll
                for (int r = 0; r < 4; ++r) { const int s = kb + 16 * i + 4 * q + r; const float zz = z[i][r] * 0.125f;
                    const float sp = fmaxf(zz, 0.f) + __logf(1.0f + __expf(-fabsf(zz)));
                    lb[i][r] = (s < tq) ? -sp : 0.f; lz[i][r] = zz - sp; tot[i] += lb[i][r]; } }
            float t1[2], t2[2], t3[2];
#pragma unroll
            for (int i = 0; i < 2; ++i) { t1[i] = shx(tot[i], 16, lane); t2[i] = shx(tot[i], 32, lane); t3[i] = shx(tot[i], 48, lane); }
            float above[2] = {0.f, 0.f}, blk = 0.f;
#pragma unroll
            for (int i2 = 0; i2 < 2; ++i2)
#pragma unroll
                for (int qq = 0; qq < 4; ++qq) { const float sg = (qq == q) ? tot[i2] : (qq == (q ^ 1)) ? t1[i2] : (qq == (q ^ 2)) ? t2[i2] : t3[i2];
                    blk += sg;
#pragma unroll
                    for (int i = 0; i < 2; ++i) if (4 * i2 + qq > 4 * i + q) above[i] += sg; }
#pragma unroll
            for (int i = 0; i < 2; ++i) { float w[4]; float suf = 0.f;
#pragma unroll
                for (int r = 3; r >= 0; --r) { const int s = kb + 16 * i + 4 * q + r; const float c = carry + above[i] + suf;
                    w[r] = (s < tq) ? __expf(lz[i][r] + c) : 0.f; suf += lb[i][r]; }
                *(LAS unsigned long long*)(Wt + fr * 40 + 16 * i + 4 * q) = pack4(w[0], w[1], w[2], w[3]); }
#pragma unroll
            for (int pp = 0; pp < 4; ++pp) { const int idx = lane + 64 * pp, key = idx >> 3, dc = idx & 7;
#pragma unroll
                for (int j = 0; j < 8; ++j) VT[(dc * 8 + j) * 40 + key] = vv[pp].s[j]; }
            SB0();
            const bf16x8 bw = *(const LAS bf16x8*)(Wt + fr * 40 + 8 * q);
#pragma unroll
            for (int i = 0; i < 4; ++i) { const bf16x8 a = *(const LAS bf16x8*)(VT + (16 * i + fr) * 40 + 8 * q); o[i] = MFMA16(a, bw, o[i]); }
            SB0();
            carry += blk;
            if (__all(carry < -30.0f)) break;
        }
        SETTLE4(o[0], o[1], o[2], o[3]); SB0();
#pragma unroll
        for (int i = 0; i < 4; ++i) *(GAS unsigned long long*)(YB + (rowbase + tq) * 256 + h * 64 + 16 * i + 4 * q) = pack4(o[i][0], o[i][1], o[i][2], o[i][3]);
    }
}

__device__ __forceinline__ void retA_phase(Frame& F) {
    const bf16* P = (const bf16*)(F.ws + WS_R3); float* KV = (float*)(F.ws + WS_KV); const f32x2* rope = (const f32x2*)(F.ws + WS_ROPE);
    LAS bf16* KT = (LAS bf16*)(F.lds + F.wave * WAVE_LDS);
    LAS bf16* VT = KT + 64 * 72;
    const int lane = pg8::launder_i(F.lane), fr = lane & 15, q = lane >> 4;
    for (int u = F.gw; u < NB * NCH * 4 * 2; u += F.NGW) {
        const int dh = u & 1, h = (u >> 1) & 3, n = (u >> 3) & 127, b = u >> 10;
        const size_t row0 = (size_t)b * SEQ + n * 64; const float l2g = gamma_log2(h);
#pragma unroll
        for (int it = 0; it < 4; ++it) { const int idx = lane + 64 * it, s = idx >> 2, pc = idx & 3;
            const bf16* kp = P + (row0 + s) * PW + C_KC + h * 64 + 8 * pc;
            BF8 lo, hi; lo.u = *(const v4u*)kp; hi.u = *(const v4u*)(kp + 32);
            const f32x4* rt = (const f32x4*)(rope + (size_t)(n * 64 + s) * 32 + 8 * pc);
            const float f = 0.125f * exp2f(l2g * (float)(63 - s));
#pragma unroll
            for (int j2 = 0; j2 < 4; ++j2) { const f32x4 cs = rt[j2];
                { const float t1 = bf2f(lo.s[2 * j2]), t2 = bf2f(hi.s[2 * j2]);
                  KT[(8 * pc + 2 * j2) * 72 + s] = (bf16)f2bf((t1 * cs.x - t2 * cs.y) * f); KT[(32 + 8 * pc + 2 * j2) * 72 + s] = (bf16)f2bf((t1 * cs.y + t2 * cs.x) * f); }
                { const float t1 = bf2f(lo.s[2 * j2 + 1]), t2 = bf2f(hi.s[2 * j2 + 1]);
                  KT[(8 * pc + 2 * j2 + 1) * 72 + s] = (bf16)f2bf((t1 * cs.z - t2 * cs.w) * f); KT[(32 + 8 * pc + 2 * j2 + 1) * 72 + s] = (bf16)f2bf((t1 * cs.w + t2 * cs.z) * f); } } }
#pragma unroll
        for (int it = 0; it < 8; ++it) { const int idx = lane + 64 * it, s = idx >> 3, dc = idx & 7;
            BF8 vv; vv.u = *(const v4u*)(P + (row0 + s) * PW + C_VC + h * 128 + dh * 64 + dc * 8);
#pragma unroll
            for (int j = 0; j < 8; ++j) VT[(dc * 8 + j) * 72 + s] = vv.s[j]; }
        f32x4 acc[4][4];
#pragma unroll
        for (int i = 0; i < 4; ++i)
#pragma unroll
            for (int jt = 0; jt < 4; ++jt) acc[i][jt] = (f32x4){0.f, 0.f, 0.f, 0.f};
        SB0();
#pragma unroll
        for (int ks = 0; ks < 2; ++ks) { bf16x8 bk[4];
#pragma unroll
            for (int jt = 0; jt < 4; ++jt) bk[jt] = *(const LAS bf16x8*)(KT + (16 * jt + fr) * 72 + 8 * q + 32 * ks);
#pragma unroll
            for (int i = 0; i < 4; ++i) { const bf16x8 a = *(const LAS bf16x8*)(VT + (16 * i + fr) * 72 + 8 * q + 32 * ks);
#pragma unroll
                for (int jt = 0; jt < 4; ++jt) acc[i][jt] = MFMA16(a, bk[jt], acc[i][jt]); } }
#pragma unroll
        for (int i = 0; i < 4; ++i) SETTLE4(acc[i][0], acc[i][1], acc[i][2], acc[i][3]); SB0();
        float* dst = KV + ((size_t)(b * NCH + n) * 4 + h) * 8192;
#pragma unroll
        for (int i = 0; i < 4; ++i)
#pragma unroll
            for (int jt = 0; jt < 4; ++jt)
#pragma unroll
                for (int r = 0; r < 4; ++r) dst[(dh * 64 + 16 * i + 4 * q + r) * 64 + 16 * jt + fr] = acc[i][jt][r];
    }
}

__device__ __forceinline__ void scanB_phase(Frame& F, int l) {
    const float* KV = (const float*)(F.ws + WS_KV); float* KV2 = F.out; const f32x2* E = (const f32x2*)(F.ws + WS_S5); f32x2* E2 = (f32x2*)(F.out + (size_t)16 * 1048576);
    const f32x2* lamc = (const f32x2*)(F.ws + S5T_LAMC + (size_t)l * S5T_LAYER);
    const int gth = blockIdx.x * (NWAVES * 64) + pg8::launder_i(F.tid), nth = F.G * NWAVES * 64;
    for (int c = gth; c < NB * 4 * 8192; c += nth) {
        const int b = c >> 15, h = (c >> 13) & 3, e = c & 8191; const float cd = exp2f(64.0f * gamma_log2(h));
        const size_t o = ((size_t)(b * NCH) * 4 + h) * 8192 + e; float s = 0.f;
#pragma unroll 8
        for (int n = 0; n < NCH; ++n) { const float kv = KV[o + (size_t)n * 32768]; KV2[o + (size_t)n * 32768] = s; s = cd * s + kv; }
    }
    for (int c = gth; c < NB * 1024; c += nth) {
        const int b = c >> 10, gp = c & 1023; const f32x2 l64 = lamc[gp * 8 + 7];
        const size_t o = (size_t)(b * NCH) * 1024 + gp; f32x2 s = (f32x2){0.f, 0.f};
#pragma unroll 8
        for (int n = 0; n < NCH; ++n) { const f32x2 en = E[o + (size_t)n * 1024]; E2[o + (size_t)n * 1024] = s;
            s = (f32x2){l64.x * s.x - l64.y * s.y + en.x, l64.x * s.y + l64.y * s.x + en.y}; }
    }
}

__device__ __forceinline__ f32x2 cmul(f32x2 a, f32x2 b) { return (f32x2){a.x * b.x - a.y * b.y, a.x * b.y + a.y * b.x}; }
__device__ __forceinline__ f32x2 cfma(f32x2 a, f32x2 b, f32x2 c) { return (f32x2){a.x * b.x - a.y * b.y + c.x, a.x * b.y + a.y * b.x + c.y}; }
template <bool FULL>
__device__ __forceinline__ void s5_phase(Frame& F, int l, size_t e_off = WS_S5) {
    const float* in11 = FIN(11);
    const bf16* P = (const bf16*)(F.ws + WS_R3); f32x2* E = (f32x2*)(F.ws + e_off); bf16* YAP = (bf16*)(F.ws + WS_YAP);
    const bf16* bbar = (const bf16*)(F.ws + S5T_BBAR + (size_t)l * S5T_LAYER); const bf16* cmat = (const bf16*)(F.ws + S5T_CMAT + (size_t)l * S5T_LAYER); const f32x2* lamc = (const f32x2*)(F.ws + S5T_LAMC + (size_t)l * S5T_LAYER);
    LAS bf16* St = (LAS bf16*)(F.lds + F.wave * WAVE_LDS);
    volatile LAS f32x2* Xs = (volatile LAS f32x2*)(F.lds + F.wave * WAVE_LDS + 9216);
    const int lane = pg8::launder_i(F.lane), fr = lane & 15, q = lane >> 4;
    for (int u = F.gw; u < NB * NCH * 16; u += F.NGW) {
        const int g = u & 15, n = (u >> 4) & 127, b = u >> 11;
        const size_t row0 = (size_t)b * SEQ + n * 64;
        bf16x8 ua[4];
#pragma unroll
        for (int it = 0; it < 4; ++it) { BF8 t; t.u = (v4u){0u, 0u, 0u, 0u}; if (q < 2) t.u = *(const v4u*)(P + (row0 + 16 * it + fr) * PW + C_UA + g * 16 + 8 * q); ua[it] = t.v; }
        f32x4 y[4];
#pragma unroll
        for (int it = 0; it < 4; ++it) y[it] = (f32x4){0.f, 0.f, 0.f, 0.f};
#pragma unroll 1
        for (int ip = 0; ip < 4; ++ip) {
            const int p = 16 * ip + fr;
            const bf16x8 bre = *(const bf16x8*)(bbar + ((size_t)g * 128 + 32 * ip + fr) * 32 + 8 * q), bim = *(const bf16x8*)(bbar + ((size_t)g * 128 + 32 * ip + 16 + fr) * 32 + 8 * q);
            const f32x2* lc = lamc + (size_t)(g * 64 + p) * 8;
            const f32x2 L1 = lc[0], L2 = lc[1], L3 = lc[2], L4 = lc[3], L8 = lc[4], L12 = lc[5], L16 = lc[6];
            const f32x2 Lq = q == 0 ? (f32x2){1.f, 0.f} : q == 1 ? L4 : q == 2 ? L8 : L12;
            f32x2 Tin = (f32x2){0.f, 0.f}, dbg = (f32x2){0.f, 0.f};
            if (FULL) Tin = ((const f32x2*)(F.out + (size_t)16 * 1048576))[((size_t)(b * NCH + n) * 16 + g) * 64 + p];
#pragma unroll
            for (int it = 0; it < 4; ++it) {
                SB0(); f32x4 zr = MFMA16(ua[it], bre, ((f32x4){0.f, 0.f, 0.f, 0.f})), zi = MFMA16(ua[it], bim, ((f32x4){0.f, 0.f, 0.f, 0.f}));
                SETTLE2(zr, zi); SB0();
                const f32x2 l0 = (f32x2){zr[0], zi[0]}, l1 = cfma(L1, l0, (f32x2){zr[1], zi[1]}), l2 = cfma(L1, l1, (f32x2){zr[2], zi[2]}), l3 = cfma(L1, l2, (f32x2){zr[3], zi[3]});
                f32x2 x = l3, yv;
#if 1
#define S5X(dst, src) do { Xs[lane] = x; asm volatile("s_waitcnt lgkmcnt(0)" ::: "memory"); dst = Xs[src]; asm volatile("s_waitcnt lgkmcnt(0)" ::: "memory"); } while (0)
                S5X(yv, lane >= 16 ? lane - 16 : lane); if (q >= 1) x = cfma(L4, yv, x);
                S5X(yv, lane >= 32 ? lane - 32 : lane); if (q >= 2) x = cfma(L8, yv, x);
                f32x2 cq; S5X(cq, lane >= 16 ? lane - 16 : lane); if (q == 0) cq = (f32x2){0.f, 0.f};
                f32x2 p3; S5X(p3, 48 + fr);
#else
                yv.x = shup(x.x, 16, lane); yv.y = shup(x.y, 16, lane); if (q >= 1) x = cfma(L4, yv, x);
                yv.x = shup(x.x, 32, lane); yv.y = shup(x.y, 32, lane); if (q >= 2) x = cfma(L8, yv, x);
                f32x2 cq; cq.x = shup(x.x, 16, lane); cq.y = shup(x.y, 16, lane); if (q == 0) cq = (f32x2){0.f, 0.f};
                f32x2 p3; p3.x = shidx(x.x, 48 + fr); p3.y = shidx(x.y, 48 + fr);
#endif
                if (FULL) {
                    const f32x2 base = cfma(Lq, Tin, cq);
                    const f32x2 s0 = cfma(L1, base, l0), s1 = cfma(L2, base, l1), s2 = cfma(L3, base, l2), s3 = cfma(L4, base, l3);
                    LAS bf16* sp = St + (16 * it + 4 * q) * 72 + 32 * (ip & 1) + fr;
                    sp[0] = (bf16)f2bf(s0.x); sp[16] = (bf16)f2bf(s0.y); sp[72] = (bf16)f2bf(s1.x); sp[72 + 16] = (bf16)f2bf(s1.y);
                    sp[144] = (bf16)f2bf(s2.x); sp[144 + 16] = (bf16)f2bf(s2.y); sp[216] = (bf16)f2bf(s3.x); sp[216 + 16] = (bf16)f2bf(s3.y);
                }
                Tin = cfma(L16, Tin, p3);
#if defined(S5V) && S5V == 2
                dbg = (f32x2){L4.x + L8.y + Lq.x, L16.y + L12.x + L2.y + L3.x};
#elif defined(S5V) && S5V == 3
                dbg = p3;
#elif defined(S5V) && S5V == 4
                dbg = cq;
#elif defined(S5V) && S5V == 11
                dbg = (f32x2){zr[0] + zr[1] + zr[2], zi[0] + zi[1] + zi[2]};
#elif defined(S5V) && S5V == 12
                dbg = L1;
#elif defined(S5V) && S5V == 13
                dbg = l1;
#elif defined(S5V) && S5V == 9
                dbg = (f32x2){zr[3], zi[3]};
#elif defined(S5V) && S5V == 10
                dbg = (f32x2){bf2f((unsigned)(unsigned short)ua[it][0]) + bf2f((unsigned)(unsigned short)ua[it][7]), bf2f((unsigned)(unsigned short)bre[0]) + bf2f((unsigned)(unsigned short)bim[7])};
#else
                dbg = l3;
#endif
            }
#if defined(S5V) && S5V >= 1
            if (!FULL) { if (q == (S5V >= 9 ? 3 : S5V >= 6 ? S5V - 5 : 0)) E[((size_t)(b * NCH + n) * 16 + g) * 64 + p] = dbg; }
#else
            if (!FULL) { if (q == 0) E[((size_t)(b * NCH + n) * 16 + g) * 64 + p] = Tin; }
#endif
            if (FULL && (ip & 1)) {
                const int hp = ip >> 1; SB0();
#pragma unroll
                for (int ks = 0; ks < 2; ++ks) { const bf16x8 cb = *(const bf16x8*)(cmat + ((size_t)g * 16 + fr) * 128 + 64 * hp + 8 * q + 32 * ks);
#pragma unroll
                    for (int it = 0; it < 4; ++it) { const bf16x8 a = *(const LAS bf16x8*)(St + (16 * it + fr) * 72 + 8 * q + 32 * ks); y[it] = MFMA16(a, cb, y[it]); } }
                SB0();
            }
        }
        if (FULL) {
            SETTLE4(y[0], y[1], y[2], y[3]); SB0();
            const float dsk = in11[l * 256 + g * 16 + fr];
#pragma unroll
            for (int it = 0; it < 4; ++it)
#pragma unroll
                for (int r = 0; r < 4; ++r) { const size_t row = row0 + 16 * it + 4 * q + r;
                    const float uv = bf2f(P[row * PW + C_UA + g * 16 + fr]); const float v = y[it][r] + dsk * uv;
                    const float a2 = 2.0f * 0.7978845608028654f * (v + 0.044715f * v * v * v); const float th = 1.0f - 2.0f / (__expf(a2) + 1.0f);
                    YAP[row * 256 + g * 16 + fr] = (bf16)f2bf(0.5f * v * (1.0f + th)); }
        }
    }
}

__device__ __forceinline__ void retC_phase(Frame& F, int l) {
    const float* in14 = FIN(14);
    const bf16* P = (const bf16*)(F.ws + WS_R3); const float* KV = F.out; const f32x2* rope = (const f32x2*)(F.ws + WS_ROPE); bf16* YC = (bf16*)(F.ws + WS_YC);
    LAS bf16* VT = (LAS bf16*)F.lds;
    LAS bf16* Pw = (LAS bf16*)(F.lds + 36864 + F.wave * 2304);
    const int lane = pg8::launder_i(F.lane), fr = lane & 15, q = lane >> 4;
    const float* gn = in14 + (size_t)l * 512;
    for (int pr = blockIdx.x; pr < NB * NCH * 2; pr += F.G) {
        const int hp = pr & 1, n = (pr >> 1) & 127, b = pr >> 8; const size_t row0 = (size_t)b * SEQ + n * 64;
#pragma unroll
        for (int it = 0; it < 4; ++it) { const int idx = F.tid + 512 * it, s = idx >> 5, c8 = idx & 31, hh = c8 >> 4, dv0 = (c8 & 15) * 8;
            BF8 vv; vv.u = *(const v4u*)(P + (row0 + s) * PW + C_VC + (2 * hp + hh) * 128 + dv0);
#pragma unroll
            for (int j = 0; j < 8; ++j) VT[(hh * 128 + dv0 + j) * 72 + s] = vv.s[j]; }
        __syncthreads();
        const int hh = F.wave >> 2, h = 2 * hp + hh, c0 = (F.wave & 3) * 16; const float l2g = gamma_log2(h);
        bf16x8 qf0, qf1;
        { const bf16* qp = P + (row0 + c0 + fr) * PW + C_QC + h * 64 + 8 * q; BF8 lo, hi, o0, o1; lo.u = *(const v4u*)qp; hi.u = *(const v4u*)(qp + 32);
          const f32x2* rt = rope + (size_t)(n * 64 + c0 + fr) * 32 + 8 * q;
#pragma unroll
          for (int j = 0; j < 8; ++j) { const f32x2 cs = rt[j]; const float t1 = bf2f(lo.s[j]), t2 = bf2f(hi.s[j]); o0.s[j] = (bf16)f2bf(t1 * cs.x - t2 * cs.y); o1.s[j] = (bf16)f2bf(t1 * cs.y + t2 * cs.x); }
          qf0 = o0.v; qf1 = o1.v; }
#pragma unroll
        for (int jt = 0; jt < 4; ++jt) {
            bf16x8 kf0, kf1;
            { const bf16* kp = P + (row0 + 16 * jt + fr) * PW + C_KC + h * 64 + 8 * q; BF8 lo, hi, o0, o1; lo.u = *(const v4u*)kp; hi.u = *(const v4u*)(kp + 32);
              const f32x2* rt = rope + (size_t)(n * 64 + 16 * jt + fr) * 32 + 8 * q;
#pragma unroll
              for (int j = 0; j < 8; ++j) { const f32x2 cs = rt[j]; const float t1 = bf2f(lo.s[j]), t2 = bf2f(hi.s[j]); o0.s[j] = (bf16)f2bf((t1 * cs.x - t2 * cs.y) * 0.125f); o1.s[j] = (bf16)f2bf((t1 * cs.y + t2 * cs.x) * 0.125f); }
              kf0 = o0.v; kf1 = o1.v; }
            SB0(); f32x4 sa = MFMA16(qf0, kf0, ((f32x4){0.f, 0.f, 0.f, 0.f})); sa = MFMA16(qf1, kf1, sa);
            SETTLE1(sa); SB0();
#pragma unroll
            for (int r = 0; r < 4; ++r) { const int c = c0 + 4 * q + r, s = 16 * jt + fr; const float dd = (float)(c > s ? c - s : s - c);
                Pw[(4 * q + r) * 72 + 16 * jt + fr] = (bf16)f2bf(sa[r] * exp2f(l2g * dd)); }
        }
        f32x4 o[8];
#pragma unroll
        for (int i = 0; i < 8; ++i) o[i] = (f32x4){0.f, 0.f, 0.f, 0.f};
        const float* SP = KV + ((size_t)(b * NCH + n) * 4 + h) * 8192;
        SB0();
#pragma unroll
        for (int i = 0; i < 8; ++i)
#pragma unroll
            for (int ks = 0; ks < 2; ++ks) { const f32x4* sp = (const f32x4*)(SP + (16 * i + fr) * 64 + 8 * q + 32 * ks); const f32x4 x0 = sp[0], x1 = sp[1];
                BF8 a; a.u = (v4u){pk2(x0.x, x0.y), pk2(x0.z, x0.w), pk2(x1.x, x1.y), pk2(x1.z, x1.w)};
                o[i] = MFMA16(a.v, ks == 0 ? qf0 : qf1, o[i]); }
        SETTLE4(o[0], o[1], o[2], o[3]); SB0(); SETTLE4(o[4], o[5], o[6], o[7]); SB0();
        const float qd = exp2f(l2g * (float)(c0 + fr + 1));
#pragma unroll
        for (int i = 0; i < 8; ++i) o[i] = o[i] * qd;
        SB0();
#pragma unroll
        for (int ks = 0; ks < 2; ++ks) { const bf16x8 bw = *(const LAS bf16x8*)(Pw + fr * 72 + 8 * q + 32 * ks);
#pragma unroll
            for (int i = 0; i < 8; ++i) { const bf16x8 a = *(const LAS bf16x8*)(VT + (hh * 128 + 16 * i + fr) * 72 + 8 * q + 32 * ks); o[i] = MFMA16(a, bw, o[i]); } }
        SETTLE4(o[0], o[1], o[2], o[3]); SB0(); SETTLE4(o[4], o[5], o[6], o[7]); SB0();
        float sm = 0.f;
#pragma unroll
        for (int i = 0; i < 8; ++i) sm += (o[i][0] + o[i][1]) + (o[i][2] + o[i][3]);
        sm += shx(sm, 16, lane); sm += shx(sm, 32, lane);
        const float mean = sm * (1.0f / 128.0f); float vs = 0.f;
#pragma unroll
        for (int i = 0; i < 8; ++i) { o[i] = o[i] - mean; vs += (o[i][0] * o[i][0] + o[i][1] * o[i][1]) + (o[i][2] * o[i][2] + o[i][3] * o[i][3]); }
        vs += shx(vs, 16, lane); vs += shx(vs, 32, lane);
        const float rstd = 1.0f / sqrtf(vs * (1.0f / 128.0f) + LN_EPS);
        const size_t row = row0 + c0 + fr;
#pragma unroll
        for (int i = 0; i < 8; ++i) { const int dv = h * 128 + 16 * i + 4 * q;
            const unsigned long long gw = *(const GAS unsigned long long*)(P + row * PW + C_GC + dv); const f32x4 gg = *(const f32x4*)(gn + dv);
            const float g0 = bf2f((unsigned)gw & 0xffffu), g1 = bf2f(((unsigned)gw) >> 16), g2 = bf2f((unsigned)(gw >> 32) & 0xffffu), g3 = bf2f((unsigned)(gw >> 48));
            *(GAS unsigned long long*)(YC + row * 512 + dv) = pack4(o[i][0] * rstd * gg.x * g0 * sigmoidf_(g0), o[i][1] * rstd * gg.y * g1 * sigmoidf_(g1),
                                                                   o[i][2] * rstd * gg.z * g2 * sigmoidf_(g2), o[i][3] * rstd * gg.w * g3 * sigmoidf_(g3)); }
        __syncthreads();
    }
}
#ifndef DIAG
#define DIAG 0
#endif
#ifndef N_LAUNCH
#define N_LAUNCH 1
#endif
__device__ __forceinline__ void diag_max(Frame& F, float m) {
    if (!(m == m)) m = 3.0e38f;
#pragma unroll
    for (int o = 1; o < 64; o <<= 1) m = fmaxf(m, shx(m, o, F.lane));
    if (F.lane == 0) atomicMax((unsigned*)F.ctl + CW_DIAG, __float_as_uint(m));
}
__device__ __forceinline__ void diag_emit(Frame& F) {
    const float m = __uint_as_float(__hip_atomic_load((unsigned*)F.ctl + CW_DIAG, RLX_AGENT));
    const float v = sqrtf(5.0f * (log10f(fminf(fmaxf(m, 1e-11f), 1e8f)) + 12.0f));
    const size_t n = (size_t)T * D, nth = (size_t)F.G * NWAVES * 64;
    for (size_t i = (size_t)blockIdx.x * (NWAVES * 64) + F.tid; i < n; i += nth) F.out[i] = v;
}
__device__ __forceinline__ unsigned hash_u(unsigned x) { x ^= x >> 16; x *= 0x7feb352du; x ^= x >> 15; x *= 0x846ca68bu; x ^= x >> 16; return x; }
__device__ __forceinline__ void diag_proj(Frame& F) {
    const float* in0 = FIN(0); const float* in1 = FIN(1); const float* in2 = FIN(2); const float* in3 = FIN(3);
    const bf16* P = (const bf16*)(F.ws + WS_R3); float worst = 0.f;
    for (int smp = F.gw; smp < 4096; smp += F.NGW) {
        const int row = hash_u(smp * 2 + 1) % T, col = hash_u(smp * 2 + 2) % PW;
        const GAS f32x4* xr = (const GAS f32x4*)(in0 + (size_t)row * D) + F.lane; f32x4 v[4];
#pragma unroll
        for (int j = 0; j < 4; ++j) v[j] = xr[64 * j];
        ln_row(v, in1, in2, F.lane);
        float s = 0.f;
#pragma unroll
        for (int j = 0; j < 4; ++j) { const int k = 4 * F.lane + 256 * j; const float* w = in3 + (size_t)k * INW + col; s += v[j].x * w[0] + v[j].y * w[INW] + v[j].z * w[2 * INW] + v[j].w * w[3 * INW]; }
        s = wave_sum(s, F.lane);
        worst = fmaxf(worst, fabsf(s - bf2f(P[(size_t)row * PW + col])));
    }
    diag_max(F, worst);
}


__device__ __forceinline__ void emit_frac(Frame& F, const bf16* src, size_t o0, size_t n) {
    const size_t nth = (size_t)F.G * NWAVES * 64;
    for (size_t i = (size_t)blockIdx.x * (NWAVES * 64) + F.tid; i < n; i += nth) { const float x = bf2f(src[i]) * 257.3f; F.out[o0 + i] = x - floorf(x); }
}
#if DIAG >= 2 && DIAG <= 5
__device__ __forceinline__ float diag_sb(Frame& F) {
    const bf16* P = (const bf16*)(F.ws + WS_R3); const bf16* YB = (const bf16*)(F.ws + WS_YB); float worst = 0.f; const int d = F.lane;
    for (int smp = F.gw; smp < 2048; smp += F.NGW) {
        const int b = hash_u(smp * 3 + 1) & 3, h = hash_u(smp * 3 + 2) & 3; int t = hash_u(smp * 3 + 3) % SEQ; if ((smp & 7) == 0) t = smp >> 3 & 63;
        const size_t rb = (size_t)b * SEQ; const float qd = bf2f(P[(rb + t) * PW + C_QB + h * 64 + d]);
        float out = 0.f, cs = 0.f;
        for (int s = t - 1; s >= 0; --s) { const float z = wave_sum(qd * bf2f(P[(rb + s) * PW + C_KB + h * 64 + d])) * 0.125f;
            const float sp = fmaxf(z, 0.f) + log1pf(expf(-fabsf(z)));
            out += expf(z - sp + cs) * bf2f(P[(rb + s) * PW + C_VB + h * 64 + d]); cs -= sp; if (cs < -100.f) break; }
        worst = fmaxf(worst, fabsf(out - bf2f(YB[(rb + t) * 256 + h * 64 + d])));
    }
    return worst;
}
__device__ __forceinline__ float diag_ret(Frame& F, int l) {
    const float* in14 = FIN(14);
    const bf16* P = (const bf16*)(F.ws + WS_R3); const bf16* YC = (const bf16*)(F.ws + WS_YC); float worst = 0.f; const int d = F.lane, fi = d & 31;
    const float invf = powf(10000.0f, -(float)fi / 32.0f);
    for (int smp = F.gw; smp < 1024; smp += F.NGW) {
        const int b = hash_u(smp * 3 + 11) & 3, h = hash_u(smp * 3 + 12) & 3; const int t = hash_u(smp * 3 + 13) % 1536;
        const size_t rb = (size_t)b * SEQ; const float gam = 1.0f - exp2f(-5.0f - (float)h), lg = logf(gam);
        float sn, cs; sincosf((float)t * invf, &sn, &cs);
        const float q1 = bf2f(P[(rb + t) * PW + C_QC + h * 64 + fi]), q2 = bf2f(P[(rb + t) * PW + C_QC + h * 64 + 32 + fi]);
        const float qr = d < 32 ? q1 * cs - q2 * sn : q1 * sn + q2 * cs;
        float o0 = 0.f, o1 = 0.f; const int pend = (t / 64) * 64 + 63;
        for (int ps = 0; ps <= pend; ++ps) { float s2, c2; sincosf((float)ps * invf, &s2, &c2);
            const float k1 = bf2f(P[(rb + ps) * PW + C_KC + h * 64 + fi]), k2 = bf2f(P[(rb + ps) * PW + C_KC + h * 64 + 32 + fi]);
            const float kr = (d < 32 ? k1 * c2 - k2 * s2 : k1 * s2 + k2 * c2) * 0.125f;
            const float sc = wave_sum(qr * kr, F.lane) * expf(lg * fabsf((float)(t - ps)));
            o0 += sc * bf2f(P[(rb + ps) * PW + C_VC + h * 128 + d]); o1 += sc * bf2f(P[(rb + ps) * PW + C_VC + h * 128 + 64 + d]); }
        const float mean = wave_sum(o0 + o1, F.lane) * (1.f / 128.f); const float a0 = o0 - mean, a1 = o1 - mean;
        const float rstd = 1.f / sqrtf(wave_sum(a0 * a0 + a1 * a1, F.lane) * (1.f / 128.f) + LN_EPS);
        const float g0 = bf2f(P[(rb + t) * PW + C_GC + h * 128 + d]), g1 = bf2f(P[(rb + t) * PW + C_GC + h * 128 + 64 + d]);
        const float r0 = a0 * rstd * in14[l * 512 + h * 128 + d] * g0 * sigmoidf_(g0), r1 = a1 * rstd * in14[l * 512 + h * 128 + 64 + d] * g1 * sigmoidf_(g1);
        worst = fmaxf(worst, fmaxf(fabsf(r0 - bf2f(YC[(rb + t) * 512 + h * 128 + d])), fabsf(r1 - bf2f(YC[(rb + t) * 512 + h * 128 + 64 + d]))));
    }
    return worst;
}
__device__ __forceinline__ float diag_s5(Frame& F, int l) {
    const float* in4 = FIN(4); const float* in5 = FIN(5); const float* in6 = FIN(6); const float* in7 = FIN(7); const float* in8 = FIN(8); const float* in9 = FIN(9); const float* in10 = FIN(10); const float* in11 = FIN(11);
    const bf16* P = (const bf16*)(F.ws + WS_R3); const bf16* YAP = (const bf16*)(F.ws + WS_YAP); float worst = 0.f; const int p = F.lane;
    for (int smp = F.gw; smp < 1024; smp += F.NGW) {
        const int b = hash_u(smp * 3 + 21) & 3, g = hash_u(smp * 3 + 22) & 15; const int t = hash_u(smp * 3 + 23) % 1024;
        const size_t rb = (size_t)b * SEQ; const int gp = l * 1024 + g * 64 + p;
        const float dt = expf(in6[l * 16 + g]), lre = in4[gp], lim = in5[gp];
        const float er = expf(lre * dt), lbr = er * cosf(lim * dt), lbi = er * sinf(lim * dt);
        const float nr = lbr - 1.f, ni = lbi, den = lre * lre + lim * lim, zr = (nr * lre + ni * lim) / den, zi = (ni * lre - nr * lim) / den;
        float sr = 0.f, si = 0.f;
        for (int ps = 0; ps <= t; ++ps) { float br = 0.f, bi = 0.f;
            for (int c = 0; c < 16; ++c) { const float uv = bf2f(P[(rb + ps) * PW + C_UA + g * 16 + c]); const float b_r = in7[(size_t)gp * 16 + c], b_i = in8[(size_t)gp * 16 + c];
                br += (b_r * zr - b_i * zi) * uv; bi += (b_r * zi + b_i * zr) * uv; }
            const float nsr = lbr * sr - lbi * si + br, nsi = lbr * si + lbi * sr + bi; sr = nsr; si = nsi; }
        for (int c = 0; c < 16; ++c) { const float cr = in9[((size_t)(l * 16 + g) * 16 + c) * 64 + p], ci = in10[((size_t)(l * 16 + g) * 16 + c) * 64 + p];
            float v = wave_sum(cr * sr - ci * si, F.lane) + in11[l * 256 + g * 16 + c] * bf2f(P[(rb + t) * PW + C_UA + g * 16 + c]);
            v = 0.5f * v * (1.0f + tanhf(0.7978845608028654f * (v + 0.044715f * v * v * v)));
            worst = fmaxf(worst, fabsf(v - bf2f(YAP[(rb + t) * 256 + g * 16 + c]))); }
    }
    return worst;
}
#endif
#ifndef DISABLE
#define DISABLE 0
#endif
struct Args { const float* in[28]; float* out; unsigned char* ws; int ph_lo, ph_hi; };
constexpr int PH_PER_LAYER = 14, N_PHASES = NLAYER * PH_PER_LAYER;
__global__ void __launch_bounds__(NWAVES * 64, 2) hse_fwd(Args args) {
    extern __shared__ __attribute__((aligned(16))) unsigned char lds_raw[];
    Frame F;
    F.lds = (LAS unsigned char*)lds_raw;
    F.MISC = (volatile LAS unsigned*)(F.lds + MISC_OFF);
    F.tid = threadIdx.x; F.lane = F.tid & 63; F.wave = __builtin_amdgcn_readfirstlane(F.tid >> 6);
    F.G = gridDim.x; { const int bx = blockIdx.x; F.vcu = (F.G % 8 == 0) ? (bx % 8) * (F.G / 8) + bx / 8 : bx; }
    F.gw = blockIdx.x * NWAVES + F.wave; F.NGW = F.G * NWAVES;
    F.ws = args.ws; F.ctl = (gu32*)(args.ws + WS_CTL); F.out = args.out;
    F.ka = (const __attribute__((address_space(4))) char*)__builtin_amdgcn_kernarg_segment_ptr();
    for (int u = F.tid; u < (LDS_BYTES - MISC_OFF) / 4; u += NWAVES * 64) ((LAS unsigned*)(F.lds + MISC_OFF))[u] = 0u;
    __syncthreads();
    XcdBarrier bar = xcd_barrier_post((unsigned*)(F.ctl + CW_BAR), F.MISC + 8);
    const int lo = args.ph_lo, hi = args.ph_hi;
#define IN(k) (lo <= (k) && (k) < hi)
#define RELAUNDER() do { F.lane = pg8::lane_id_opaque(); F.tid = F.wave * 64 + F.lane; F.ws = pg8::launder_p(F.ws); F.ctl = (gu32*)F.ws; F.out = pg8::launder_p(F.out); } while (0)
#define SEAM(k) do { if (IN(k) && IN((k) + 1)) xcd_barrier(bar); RELAUNDER(); } while (0)
    PG8_LAS unsigned char* ring = (PG8_LAS unsigned char*)F.lds;
    typedef pg8::bf16_t b16;
    if (IN(0)) { rope_table(F); s5_tables(F, 0); s5_tables(F, 1); ln0_phase(F); }
#ifdef ZERO_E
    { unsigned* Ez = (unsigned*)(F.ws + WS_S5); for (size_t i = (size_t)blockIdx.x * (NWAVES * 64) + F.tid; i < (size_t)NB * NCH * 2048; i += (size_t)F.G * NWAVES * 64) Ez[i] = 0x7fc00000u; }
#endif
#pragma unroll 1
    for (int l = 0; l < NLAYER; ++l) {
        const int pb = l * PH_PER_LAYER; RELAUNDER();
        if (!((DISABLE >> 0) & 1) && IN(pb + 0)) conv_weights(F, l);
#if DIAG == 30
        if (l == 0) { xcd_barrier(bar); { const size_t n = (size_t)T * D, nth = (size_t)F.G * NWAVES * 64; const float* Ef = (const float*)(F.ws + S5T_LAMC); const bf16* Bb = (const bf16*)(F.ws + S5T_BBAR);
            for (size_t i = (size_t)blockIdx.x * (NWAVES * 64) + F.tid; i < n; i += nth) { float v = 0.f; if (i < 16384) { const float x = Ef[i] * 1000.0f; v = x - floorf(x); } else if (i < 16384 + 98304) { const float x = bf2f(Bb[i - 16384]) * 257.3f; v = x - floorf(x); } F.out[i] = v; } } return; }
#endif
        SEAM(pb + 0);
        if (!((DISABLE >> 1) & 1) && IN(pb + 1)) { pg8::Gemm g{(const b16*)(F.ws + WS_H), (const b16*)(F.ws + W_IN), D}; pg8::StaticOrder S; S.init(T, PW, F.G, (int)blockIdx.x);
            pg8::EpiStore E{(b16*)(F.ws + WS_R3), PW}; pg8::gemm_phase<pg8::EpiStore, pg8::StaticOrder>(ring, g, S, E, F.wave); }
#if DIAG == 1
        if (l == 0) { xcd_barrier(bar); diag_proj(F); xcd_barrier(bar); diag_emit(F); return; }
#endif
#if DIAG == 32
        if (l == 0) { xcd_barrier(bar); { const size_t n = (size_t)T * D, nth = (size_t)F.G * NWAVES * 64; const bf16* Pp = (const bf16*)(F.ws + WS_R3);
            for (size_t i = (size_t)blockIdx.x * (NWAVES * 64) + F.tid; i < n; i += nth) { const size_t r = i >> 10, c = i & 1023; float v = 0.f; if (c < 256) { const float x = bf2f(Pp[r * PW + c]) * 257.3f; v = x - floorf(x); } F.out[i] = v; } } return; }
#endif
#if DIAG == 20
        if (l == 0) { xcd_barrier(bar); emit_frac(F, (const bf16*)(F.ws + WS_R3), 0, (size_t)T * D); return; }
#endif
        SEAM(pb + 1);
        if (!((DISABLE >> 2) & 1) && IN(pb + 2)) { s5_phase<false>(F, l); retA_phase(F); sb_phase(F); }
#if DIAG == 31
        if (l == 0) { xcd_barrier(bar); s5_phase<false>(F, l, WS_KV); xcd_barrier(bar);
            { const unsigned* A = (const unsigned*)(F.ws + WS_S5); const unsigned* B = (const unsigned*)(F.ws + WS_KV); float cnt = 0.f; const size_t nth = (size_t)F.G * NWAVES * 64;
              for (size_t i = (size_t)blockIdx.x * (NWAVES * 64) + F.tid; i < (size_t)NB * NCH * 2048; i += nth) cnt += (A[i] != B[i]) ? 1.0f : 0.0f;
              cnt = wave_sum(cnt, F.lane); if (F.lane == 0 && cnt > 0.f) atomicAdd((float*)F.ctl + CW_DIAG, cnt); }
            xcd_barrier(bar); diag_emit(F); return; }
#endif
#if DIAG == 28
        if (l == 0) { xcd_barrier(bar); { const size_t n = (size_t)T * D, nth = (size_t)F.G * NWAVES * 64; const float* Ef = (const float*)(F.ws + WS_S5);
            for (size_t i = (size_t)blockIdx.x * (NWAVES * 64) + F.tid; i < n; i += nth) { float v = 0.f; if (i < (size_t)NB * NCH * 2048) { const float x = Ef[i] * 1000.0f; v = x - floorf(x); } F.out[i] = v; } } return; }
#endif
        SEAM(pb + 2);
        if (!((DISABLE >> 3) & 1) && IN(pb + 3)) scanB_phase(F, l);
#if DIAG == 29
        if (l == 0) { xcd_barrier(bar); { const size_t n = (size_t)T * D, nth = (size_t)F.G * NWAVES * 64; const float* Ef = (const float*)(F.ws + WS_S5);
            for (size_t i = (size_t)blockIdx.x * (NWAVES * 64) + F.tid; i < n; i += nth) { float v = 0.f; if (i < (size_t)NB * NCH * 2048) { const float x = Ef[i] * 1000.0f; v = x - floorf(x); } F.out[i] = v; } } return; }
#endif
        SEAM(pb + 3);
        if (!((DISABLE >> 4) & 1) && IN(pb + 4)) { s5_phase<true>(F, l); __syncthreads(); retC_phase(F, l); }
#if DIAG >= 2 && DIAG <= 5
        if (l == 0) { xcd_barrier(bar); float m = 0.f;
            if (DIAG == 2 || DIAG == 3) m = fmaxf(m, diag_s5(F, l));
            if (DIAG == 2 || DIAG == 4) m = fmaxf(m, diag_sb(F));
            if (DIAG == 2 || DIAG == 5) m = fmaxf(m, diag_ret(F, l));
            diag_max(F, m); xcd_barrier(bar); diag_emit(F); return; }
#endif
#if DIAG >= 25 && DIAG <= 27
        if (l == 0) { xcd_barrier(bar); { const size_t n = (size_t)T * D, nth = (size_t)F.G * NWAVES * 64; for (size_t i = (size_t)blockIdx.x * (NWAVES * 64) + F.tid; i < n; i += nth) F.out[i] = 0.f; } xcd_barrier(bar);
            if (DIAG == 25) emit_frac(F, (const bf16*)(F.ws + WS_YC), 0, (size_t)T * 512); if (DIAG == 26) emit_frac(F, (const bf16*)(F.ws + WS_YAP), 0, (size_t)T * 256); if (DIAG == 27) emit_frac(F, (const bf16*)(F.ws + WS_YB), 0, (size_t)T * 256); return; }
#endif
#if DIAG == 21
        if (l == 0) { xcd_barrier(bar); emit_frac(F, (const bf16*)(F.ws + WS_YC), 0, (size_t)T * 512); emit_frac(F, (const bf16*)(F.ws + WS_YAP), (size_t)T * 512, (size_t)T * 256); emit_frac(F, (const bf16*)(F.ws + WS_YB), (size_t)T * 768, (size_t)T * 256); return; }
#endif
        SEAM(pb + 4);
        if (!((DISABLE >> 5) & 1) && IN(pb + 5)) { pg8::Gemm g{(const b16*)(F.ws + WS_YAP), (const b16*)(F.ws + W_GLU), 256}; pg8::StaticOrder S; S.init(T, 256, F.G, (int)blockIdx.x);
            pg8::EpiGlu E{(const b16*)(F.ws + WS_YAP), (b16*)(F.ws + WS_YA), FIN(13) + (size_t)l * 256}; pg8::gemm_phase<pg8::EpiGlu, pg8::StaticOrder>(ring, g, S, E, F.wave); }
        SEAM(pb + 5);
        if (!((DISABLE >> 6) & 1) && IN(pb + 6)) {
            { pg8::Gemm g{(const b16*)(F.ws + WS_YA), (const b16*)(F.ws + W_UPA), 256}; pg8::StaticOrder S; S.init(T, D, F.G, (int)blockIdx.x); pg8::EpiStore E{(b16*)(F.ws + WS_R3), 3072}; pg8::gemm_phase<pg8::EpiStore, pg8::StaticOrder>(ring, g, S, E, F.wave); }
            { pg8::Gemm g{(const b16*)(F.ws + WS_YB), (const b16*)(F.ws + W_UPB), 256}; pg8::StaticOrder S; S.init(T, D, F.G, (int)blockIdx.x); pg8::EpiStore E{(b16*)(F.ws + WS_R3) + 1024, 3072}; pg8::gemm_phase<pg8::EpiStore, pg8::StaticOrder>(ring, g, S, E, F.wave); }
            { pg8::Gemm g{(const b16*)(F.ws + WS_YC), (const b16*)(F.ws + W_UPC), 512}; pg8::StaticOrder S; S.init(T, D, F.G, (int)blockIdx.x); pg8::EpiStore E{(b16*)(F.ws + WS_R3) + 2048, 3072}; pg8::gemm_phase<pg8::EpiStore, pg8::StaticOrder>(ring, g, S, E, F.wave); }
        }
#if DIAG == 22
        if (l == 0) { xcd_barrier(bar); emit_frac(F, (const bf16*)(F.ws + WS_R3), 0, (size_t)T * D); return; }
#endif
        SEAM(pb + 6);
        if (!((DISABLE >> 7) & 1) && IN(pb + 7)) { pg8::Gemm g{(const b16*)(F.ws + WS_H), (const b16*)(F.ws + W_IN) + (size_t)PW * D, D}; pg8::GateOrder S{F.G, F.vcu};
            pg8::EpiGate E{(const b16*)(F.ws + WS_R3), F.out, (b16*)(F.ws + WS_MRG)}; pg8::gemm_phase<pg8::EpiGate, pg8::GateOrder>(ring, g, S, E, F.wave); }
#if DIAG == 23
        if (l == 0) { xcd_barrier(bar); emit_frac(F, (const bf16*)(F.ws + WS_MRG), 0, (size_t)T * D); return; }
#endif
        SEAM(pb + 7);
        if (!((DISABLE >> 8) & 1) && IN(pb + 8)) { pg8::Gemm g{(const b16*)(F.ws + WS_MRG), (const b16*)(F.ws + W_OUT), D}; pg8::StaticOrder S; S.init(T, D, F.G, (int)blockIdx.x);
            pg8::EpiOut E{(const b16*)(F.ws + WS_H), (b16*)(F.ws + WS_R3)}; pg8::gemm_phase<pg8::EpiOut, pg8::StaticOrder>(ring, g, S, E, F.wave); }
#if DIAG == 24
        if (l == 0) { xcd_barrier(bar); emit_frac(F, (const bf16*)(F.ws + WS_R3), 0, (size_t)T * D); return; }
#endif
        SEAM(pb + 8);
        if (!((DISABLE >> 9) & 1) && IN(pb + 9)) ln1_route_phase(F, l);
#if DIAG == 11
        if (l == 0) return;
#endif
#if DIAG == 10
        if (l == 0) { LAS int* sel_e = (LAS int*)(F.lds + 65536); LAS float* sel_g = (LAS float*)(F.lds + 65536 + 1024); LAS int* rnk = (LAS int*)(F.lds + 65536 + 2048);
            for (int i = F.tid; i < 128 * 1024; i += NWAVES * 64) { const int tl = i >> 10, c = i & 1023; float v = 0.f;
                if (c < 2) v = (float)sel_e[2 * tl + c]; else if (c < 4) v = sel_g[2 * tl + c - 2]; else if (c < 6) v = (float)rnk[2 * tl + c - 4];
                F.out[(size_t)(blockIdx.x * 128 + tl) * 1024 + c] = v; } return; }
#endif
#if DIAG == 6
        if (l == 0) { xcd_barrier(bar); const bf16* Hd = (const bf16*)(F.ws + WS_H); const size_t n = (size_t)T * D, nth = (size_t)F.G * NWAVES * 64;
            for (size_t i = (size_t)blockIdx.x * (NWAVES * 64) + F.tid; i < n; i += nth) F.out[i] = bf2f(Hd[i]); return; }
#endif
        SEAM(pb + 9);
        if (!((DISABLE >> 10) & 1) && IN(pb + 10)) dispatch_phase(F);
#if DIAG == 9
        if (l == 0) { xcd_barrier(bar); volatile LAS int* tabd = (volatile LAS int*)(F.MISC + 16); moe_table(F, tabd); const int* lst = (const int*)(F.ws + WS_LIST); const size_t n = (size_t)T * D, nth = (size_t)F.G * NWAVES * 64;
            for (size_t i = (size_t)blockIdx.x * (NWAVES * 64) + F.tid; i < n; i += nth) { const int k = (int)(i & 524287), e = k >> 15, pos = k & 32767; F.out[i] = pos < tabd[e] ? (float)(lst[k] & 1023) : -1.0f; } return; }
#endif
        SEAM(pb + 10);
        if (!((DISABLE >> 11) & 1) && IN(pb + 11)) { volatile LAS int* tab = (volatile LAS int*)(F.MISC + 16); const int NP = moe_table(F, tab);
            pg8::Gemm g{(const b16*)(F.ws + WS_H), (const b16*)(F.ws + W_13), D}; pg8::MoeOrder S{tab, (const int*)(F.ws + WS_LIST), 8, F.G, F.vcu, NP};
            pg8::EpiFfn1 E{(b16*)(F.ws + WS_R3)}; pg8::gemm_phase<pg8::EpiFfn1, pg8::MoeOrder, true>(ring, g, S, E, F.wave); }
#if DIAG == 8
        if (l == 0) { xcd_barrier(bar); const bf16* Hd = (const bf16*)(F.ws + WS_R3); const size_t n = (size_t)T * D, nth = (size_t)F.G * NWAVES * 64;
            for (size_t i = (size_t)blockIdx.x * (NWAVES * 64) + F.tid; i < n; i += nth) F.out[i] = bf2f(Hd[i]); return; }
#endif
        SEAM(pb + 11);
        if (!((DISABLE >> 12) & 1) && IN(pb + 12)) { volatile LAS int* tab = (volatile LAS int*)(F.MISC + 16); const int NP = moe_table(F, tab);
            pg8::Gemm g{(const b16*)(F.ws + WS_R3), (const b16*)(F.ws + W_2), FF}; pg8::MoeOrder S{tab, (const int*)(F.ws + WS_LIST), 4, F.G, F.vcu, NP};
            pg8::EpiFfn2 E{(const int*)(F.ws + WS_LIST), (const float*)(F.ws + WS_LIST + 2 * MiB), (b16*)F.out}; pg8::gemm_phase<pg8::EpiFfn2, pg8::MoeOrder>(ring, g, S, E, F.wave); }
        SEAM(pb + 12);
        if (!((DISABLE >> 13) & 1) && IN(pb + 13)) ln2_phase(F, l, l == NLAYER - 1);
#if DIAG == 7
        if (l == 0) { xcd_barrier(bar); const bf16* Hd = (const bf16*)(F.ws + WS_H); const size_t n = (size_t)T * D, nth = (size_t)F.G * NWAVES * 64;
            for (size_t i = (size_t)blockIdx.x * (NWAVES * 64) + F.tid; i < n; i += nth) F.out[i] = bf2f(Hd[i]); return; }
#endif
        if (l + 1 < NLAYER) SEAM(pb + 13);
    }
#undef IN
#undef SEAM
}

extern "C" void kernel_launch(void* const* d_in, const int* in_sizes, int n_in, void* d_out, int out_size, void* d_ws, size_t ws_size, hipStream_t stream) {
    static int grid = 0;
    if (grid == 0) {
        if (n_in != 28 || in_sizes[0] != T * D || out_size != T * D || ws_size < WS_END) { fprintf(stderr, "kernel_launch: unexpected shapes (n_in %d, in0 %d, out %d, ws %zu < %zu)\n", n_in, n_in > 0 ? in_sizes[0] : -1, out_size, ws_size, (size_t)WS_END); grid = -1; return; }
        int dev = 0, cus = 0, per_cu = 0;
        if (hipGetDevice(&dev) != hipSuccess || hipDeviceGetAttribute(&cus, hipDeviceAttributeMultiprocessorCount, dev) != hipSuccess) { grid = -1; return; }
        if (hipFuncSetAttribute((const void*)hse_fwd, hipFuncAttributeMaxDynamicSharedMemorySize, LDS_BYTES) != hipSuccess) { fprintf(stderr, "kernel_launch: hipFuncSetAttribute(%d) failed\n", LDS_BYTES); grid = -1; return; }
        if (hipOccupancyMaxActiveBlocksPerMultiprocessor(&per_cu, (const void*)hse_fwd, NWAVES * 64, LDS_BYTES) != hipSuccess || per_cu < 1) fprintf(stderr, "kernel_launch: occupancy query reports %d\n", per_cu);
        (void)hipGetLastError();
        if (cus < T / 128) { fprintf(stderr, "kernel_launch: needs %d CUs, device has %d\n", T / 128, cus); grid = -1; return; }
        grid = T / 128;
    }
    if (grid < 0) return;
    (void)hipMemsetAsync((char*)d_ws + WS_CTL, 0, CTL_ZERO_BYTES, stream);
    Args a{};
    for (int i = 0; i < 28; ++i) a.in[i] = (const float*)d_in[i];
    a.out = (float*)d_out; a.ws = (unsigned char*)d_ws;
#if N_LAUNCH == 1
    a.ph_lo = 0; a.ph_hi = N_PHASES;
    hipLaunchKernelGGL(hse_fwd, dim3(grid), dim3(NWAVES * 64), LDS_BYTES, stream, a);
#else
    for (int p = 0; p < N_PHASES; ++p) { a.ph_lo = p; a.ph_hi = p + 1; hipLaunchKernelGGL(hse_fwd, dim3(grid), dim3(NWAVES * 64), LDS_BYTES, stream, a); }
#endif
}
```

```cpp
#include <hip/hip_runtime.h>
#include <cstdio>
#include <cstdint>
#define DIAG 0
#define N_LAUNCH 1
namespace pg8 {
#define PG8_LAS __attribute__((address_space(3)))
typedef unsigned short bf16_t;
typedef short bf16x8 __attribute__((ext_vector_type(8)));
typedef float f32x4 __attribute__((ext_vector_type(4)));
typedef unsigned u32x4 __attribute__((ext_vector_type(4)));
typedef unsigned u32x2 __attribute__((ext_vector_type(2)));
constexpr int BM = 256, BK = 64, HALF = 128, HTB = HALF * BK * 2, STAGE_BYTES = 8 * HTB, NXCD = 8, WGM = 8;

__host__ __device__ __forceinline__ int lds_byte(int r, int c) { const int st = (r >> 4) * 2 + (c >> 5), rr = r & 15, cc = c & 31, ob = rr * 64 + cc * 2; return st * 1024 + (ob ^ (((ob >> 9) & 1) << 5)); }
__host__ __device__ __forceinline__ void stage_rc(int b, int& R, int& C) { const int st = b / 1024, sb = b % 1024, swz = sb ^ (((sb >> 9) & 1) << 5); R = (st >> 1) * 16 + swz / 64; C = (st & 1) * 32 + (swz % 64) / 2; }
__host__ __device__ __forceinline__ int perm32(int rho) { const int n = rho >> 4, i = rho & 15; return 8 * (i >> 2) + 4 * n + (i & 3); }

struct Unit { int pm, pn, e, pl, cnt; };
struct Gemm { const bf16_t* A; const bf16_t* Bt; int K; };

struct StaticOrder {
    int nM, nN, nwg, G, c;
    __host__ __device__ void init(int M, int N, int G_, int c_) { nM = M / BM; nN = N / BM; nwg = nM * nN; G = G_; c = c_; }
    __host__ __device__ bool next(int i, Unit& u) const {
        const long L = (long)i * G + c; if (L >= nwg) return false;
        int wgid = (int)L; { const int q = nwg / NXCD, r = nwg % NXCD, xcd = wgid % NXCD, off = wgid / NXCD; wgid = (xcd < r ? xcd * (q + 1) : r * (q + 1) + (xcd - r) * q) + off; }
        const int nig = WGM * nN, gid = wgid / nig, fm = gid * WGM, gsz = (nM - fm) < WGM ? (nM - fm) : WGM;
        u.pm = fm + ((wgid % nig) % gsz); u.pn = (wgid % nig) / gsz; u.e = 0; u.pl = 0; u.cnt = 0; return true;
    }
    __device__ __forceinline__ int a_row(const Unit&, int) const { return 0; }
};

__device__ __forceinline__ int launder_i(int x) { asm volatile("" : "+v"(x)); return x; }
__device__ __forceinline__ int lane_id_opaque() { int x; asm volatile("v_mbcnt_lo_u32_b32 %0, -1, 0\n\tv_mbcnt_hi_u32_b32 %0, -1, %0" : "=v"(x)); return x; }
template <class T> __device__ __forceinline__ T* launder_p(T* p) { __attribute__((address_space(1))) T* g = (__attribute__((address_space(1))) T*)p; asm volatile("" : "+s"(g)); return (T*)g; }
__device__ __forceinline__ unsigned cvt_pk_bf16(float lo, float hi) { unsigned r; asm volatile("v_cvt_pk_bf16_f32 %0, %1, %2" : "=v"(r) : "v"(lo), "v"(hi)); return r; }
__device__ __forceinline__ float bf_lo(unsigned w) { return __uint_as_float(w << 16); }
__device__ __forceinline__ float bf_hi(unsigned w) { return __uint_as_float(w & 0xffff0000u); }


template <class Epi, class Sched, bool GATHER = false>
__device__ __forceinline__ void gemm_phase(PG8_LAS unsigned char* lds, const Gemm g, const Sched& S, const Epi& E, const int wave_id) {
    const int lane = lane_id_opaque(), wid = wave_id, tid = wid * 64 + lane, wr = wid >> 2, wc = wid & 3, fr = lane & 15, fq = lane >> 4;
    const int K = g.K, nt = K / BK;
    unsigned voffA[2], voffB[2];
#pragma unroll
    for (int i = 0; i < 2; ++i) { int R, C; stage_rc(tid * 16 + i * 8192, R, C); const int Rb = ((R & ~31) + perm32(R & 31));
        voffA[i] = (unsigned)(R * K + C) * 2u; voffB[i] = (unsigned)(Rb * K + C) * 2u; }
    const size_t kstep = (size_t)(BK * 2);
    const size_t hstep = (size_t)HALF * K * 2;
    const size_t tstep = 2 * hstep;
    const unsigned ldsw = (unsigned)wid * 1024u;
    const int aoff = lds_byte(wr * 64 + fr, fq * 8), boff = lds_byte(wc * 32 + fr, fq * 8);
#define PG8_SA(b, h) (((b) * 2 + (h)) * HTB)
#define PG8_SB(b, h) ((4 + (b) * 2 + (h)) * HTB)
#define PG8_STAGE(bufoff, gbase, voff) do { _Pragma("unroll") for (int _i = 0; _i < 2; ++_i) \
        __builtin_amdgcn_global_load_lds((const unsigned*)((const char*)(gbase) + (voff)[_i]), (PG8_LAS unsigned*)(lds + (bufoff) + ldsw + _i * 8192), 16, 0, 0); } while (0)
#define PG8_STAGE_A(b, h, koff, useN) do { if constexpr (GATHER) { const char* _gb = (const char*)g.A + (koff); PG8_STAGE(PG8_SA(b, h), _gb, voffC[h]); } \
        else { const char* _gb = ((useN) ? nA : cA) + (koff) + (h) * hstep; PG8_STAGE(PG8_SA(b, h), _gb, voffA); } } while (0)
#define PG8_LDA(dst, b, h) do { _Pragma("unroll") for (int m = 0; m < 4; ++m) _Pragma("unroll") for (int k = 0; k < 2; ++k) dst[m][k] = *(const PG8_LAS bf16x8*)(lds + PG8_SA(b, h) + aoff + m * 2048 + k * 1024); } while (0)
#define PG8_LDB(dst, b, h) do { _Pragma("unroll") for (int n = 0; n < 2; ++n) _Pragma("unroll") for (int k = 0; k < 2; ++k) dst[n][k] = *(const PG8_LAS bf16x8*)(lds + PG8_SB(b, h) + boff + n * 2048 + k * 1024); } while (0)
#define PG8_MMA(ai, bj, At, Bt) do { __builtin_amdgcn_s_setprio(1); _Pragma("unroll") for (int m = 0; m < 4; ++m) _Pragma("unroll") for (int n = 0; n < 2; ++n) _Pragma("unroll") for (int k = 0; k < 2; ++k) \
        acc[ai][bj][m][n] = __builtin_amdgcn_mfma_f32_16x16x32_bf16(Bt[n][k], At[m][k], acc[ai][bj][m][n], 0, 0, 0); __builtin_amdgcn_s_setprio(0); } while (0)
#define PG8_WAIT_V(n) asm volatile("s_waitcnt vmcnt(" #n ")" ::: "memory")
#define PG8_WAIT_L(n) asm volatile("s_waitcnt lgkmcnt(" #n ")" ::: "memory")
#define PG8_BAR __builtin_amdgcn_s_barrier()
#define PG8_SCHED __builtin_amdgcn_sched_barrier(0)
    Unit cur, nxt; int ui = 0;
    if (!S.next(0, cur)) return;
    f32x4 acc[2][2][4][2];
#pragma unroll
    for (int a = 0; a < 2; ++a)
#pragma unroll
        for (int b = 0; b < 2; ++b)
#pragma unroll
            for (int m = 0; m < 4; ++m)
#pragma unroll
                for (int n = 0; n < 2; ++n) acc[a][b][m][n] = (f32x4){0.f, 0.f, 0.f, 0.f};
    bf16x8 At[4][2], B0[2][2], B1[2][2];
    const char* cA = (const char*)g.A + (size_t)cur.pm * tstep; const char* cB = (const char*)g.Bt + (size_t)cur.pn * tstep;
    const char* nA = cA;
    unsigned voffC[2][2];
#define PG8_GOFF(unit) do { _Pragma("unroll") for (int h = 0; h < 2; ++h) _Pragma("unroll") for (int i = 0; i < 2; ++i) { int R, C; stage_rc(tid * 16 + i * 8192, R, C); \
        voffC[h][i] = (unsigned)(S.a_row(unit, h * HALF + R) * K + C) * 2u; } } while (0)
    if constexpr (GATHER) PG8_GOFF(cur);
    PG8_STAGE(PG8_SB(0, 0), cB, voffB); PG8_STAGE(PG8_SB(0, 1), cB + hstep, voffB); PG8_STAGE_A(0, 0, 0, false); PG8_STAGE_A(0, 1, 0, false);
    if (wr == 1) PG8_BAR;
    PG8_WAIT_V(2); PG8_BAR;
    PG8_STAGE(PG8_SB(1, 0), cB + kstep, voffB); PG8_STAGE_A(1, 0, kstep, false); PG8_STAGE(PG8_SB(1, 1), cB + hstep + kstep, voffB);
    PG8_WAIT_V(6); PG8_BAR;
    for (;;) {
        const bool has_next = S.next(ui + 1, nxt);
        nA = has_next ? (const char*)g.A + (size_t)nxt.pm * tstep : cA; const char* nB = has_next ? (const char*)g.Bt + (size_t)nxt.pn * tstep : cB;
        for (int t = 0; t < nt; t += 2) {
            const bool last = (t == nt - 2);
            const size_t k1 = (size_t)(t + 1) * kstep;
            const size_t k2 = last ? 0 : (size_t)(t + 2) * kstep, k3 = k2 + kstep;
            const char* b2 = last ? nB : cB + (size_t)(t + 2) * kstep; const char* b3 = b2 + kstep;
            PG8_LDB(B0, 0, 0); PG8_LDB(B1, 0, 1); PG8_SCHED; PG8_LDA(At, 0, 0); PG8_STAGE_A(1, 1, k1, false);
            if constexpr (GATHER) { if (last && has_next) PG8_GOFF(nxt); }
            PG8_WAIT_V(8); PG8_WAIT_L(0); PG8_BAR; PG8_MMA(0, 0, At, B0); PG8_MMA(0, 1, At, B1); PG8_BAR; PG8_SCHED;
            PG8_LDA(At, 0, 1); PG8_STAGE(PG8_SB(0, 0), b2, voffB); PG8_STAGE(PG8_SB(0, 1), b2 + hstep, voffB); PG8_STAGE_A(0, 0, k2, last);
            PG8_WAIT_V(8); PG8_WAIT_L(0); PG8_BAR; PG8_MMA(1, 0, At, B0); PG8_MMA(1, 1, At, B1); PG8_BAR; PG8_SCHED;
            PG8_LDB(B0, 1, 0); PG8_LDB(B1, 1, 1); PG8_SCHED; PG8_LDA(At, 1, 0); PG8_STAGE_A(0, 1, k2, last);
            PG8_WAIT_V(8); PG8_WAIT_L(0); PG8_BAR; PG8_MMA(0, 0, At, B0); PG8_MMA(0, 1, At, B1); PG8_BAR; PG8_SCHED;
            PG8_LDA(At, 1, 1); PG8_STAGE(PG8_SB(1, 0), b3, voffB); PG8_STAGE(PG8_SB(1, 1), b3 + hstep, voffB); PG8_STAGE_A(1, 0, k3, last);
            PG8_WAIT_V(8); PG8_WAIT_L(0); PG8_BAR; PG8_MMA(1, 0, At, B0); PG8_MMA(1, 1, At, B1); PG8_BAR; PG8_SCHED;
        }
        if (wr == 0) PG8_BAR;
        PG8_SCHED; asm volatile("s_nop 15"); PG8_SCHED;
        E(acc, cur, wr, wc, fr, fq);
        if (!has_next) break;
#pragma unroll
        for (int a = 0; a < 2; ++a)
#pragma unroll
            for (int b = 0; b < 2; ++b)
#pragma unroll
                for (int m = 0; m < 4; ++m)
#pragma unroll
                    for (int n = 0; n < 2; ++n) acc[a][b][m][n] = (f32x4){0.f, 0.f, 0.f, 0.f};
        cur = nxt; cA = nA; cB = nB; ++ui;
        if (wr == 1) PG8_BAR;
    }
    PG8_WAIT_V(0);
    PG8_BAR;
#undef PG8_SA
#undef PG8_SB
#undef PG8_STAGE
#undef PG8_STAGE_A
#undef PG8_GOFF
#undef PG8_LDA
#undef PG8_LDB
#undef PG8_MMA
#undef PG8_WAIT_V
#undef PG8_WAIT_L
#undef PG8_BAR
#undef PG8_SCHED
}
}
constexpr int NB = 4, SEQ = 8192, T = NB * SEQ, D = 1024, NCH = SEQ / 64, NLAYER = 2;
constexpr int PW = 2560;
constexpr int C_UA = 0, C_QB = 256, C_KB = 512, C_VB = 768, C_QC = 1024, C_KC = 1280, C_VC = 1536, C_GC = 2048;
constexpr int INW = 5632, NE = 16, FF = 1024;
constexpr float ALPHA = 1.41421356237309515f;
constexpr float LN_EPS = 1e-5f;
constexpr int NWAVES = 8;
constexpr size_t MiB = 1u << 20;
constexpr size_t WS_CTL = 0, CTL_ZERO_BYTES = 1 * MiB;
constexpr size_t WS_ROPE = 1 * MiB;
constexpr size_t WS_S5T = 3 * MiB;
constexpr size_t S5T_BBAR = WS_S5T, S5T_CMAT = WS_S5T + 131072, S5T_LAMC = WS_S5T + 196608, S5T_LAYER = 262144;
constexpr size_t W_IN = 4 * MiB;
constexpr size_t W_UPA = W_IN + 11 * MiB;
constexpr size_t W_UPB = W_UPA + MiB / 2;
constexpr size_t W_UPC = W_UPB + MiB / 2;
constexpr size_t W_OUT = W_UPC + MiB;
constexpr size_t W_GLU = W_OUT + 2 * MiB;
constexpr size_t W_13 = W_GLU + MiB;
constexpr size_t W_2 = W_13 + 64 * MiB;
constexpr size_t WS_H = 116 * MiB;
constexpr size_t WS_R3 = 180 * MiB;
constexpr size_t WS_R4 = 372 * MiB;
constexpr size_t WS_YAP = WS_R4, WS_YA = WS_R4 + 16 * MiB, WS_YB = WS_R4 + 32 * MiB, WS_YC = WS_R4 + 48 * MiB, WS_MRG = WS_R4;
constexpr size_t WS_S5 = 452 * MiB;
constexpr size_t WS_KV = 456 * MiB;
constexpr size_t WS_LIST = 520 * MiB;
constexpr size_t WS_BCNT = 524 * MiB;
constexpr size_t WS_END = 525 * MiB;
static_assert(W_2 + 32 * MiB == WS_H, "weight region");
constexpr int CW_TMO = 0, CW_DIAG = 64, CW_BAR = 4096, CW_CNT = 16384;
constexpr int WAVE_LDS = 18432;
constexpr int MISC_OFF = 8 * WAVE_LDS;
constexpr int LDS_BYTES = MISC_OFF + 8192;

#define GAS __attribute__((address_space(1)))
#define LAS __attribute__((address_space(3)))
typedef unsigned short bf16;
typedef unsigned v4u __attribute__((ext_vector_type(4)));
typedef unsigned v2u __attribute__((ext_vector_type(2)));
typedef float f32x4 __attribute__((ext_vector_type(4)));
typedef float f32x2 __attribute__((ext_vector_type(2)));
typedef short bf16x8 __attribute__((ext_vector_type(8)));
typedef GAS unsigned gu32;
#define RLX_AGENT __ATOMIC_RELAXED, __HIP_MEMORY_SCOPE_AGENT
#define LDS_WAIT() asm volatile("s_waitcnt lgkmcnt(0)" ::: "memory")
#define VM_WAIT() asm volatile("s_waitcnt vmcnt(0)" ::: "memory")
__device__ __forceinline__ unsigned f2bf(float f) { unsigned u = __builtin_bit_cast(unsigned, f); return (u + 0x7fffu + ((u >> 16) & 1u)) >> 16; }
__device__ __forceinline__ unsigned pk2(float lo, float hi) { return f2bf(lo) | (f2bf(hi) << 16); }
__device__ __forceinline__ float bf2f(unsigned b) { return __uint_as_float(b << 16); }
__device__ __forceinline__ float shx(float v, int o, int lane) { return __int_as_float(__builtin_amdgcn_ds_bpermute((lane ^ o) << 2, __float_as_int(v))); }
__device__ __forceinline__ float shup(float v, int d, int lane) { const int src = lane >= d ? lane - d : lane; return __int_as_float(__builtin_amdgcn_ds_bpermute(src << 2, __float_as_int(v))); }
__device__ __forceinline__ float shidx(float v, int src) { return __int_as_float(__builtin_amdgcn_ds_bpermute(src << 2, __float_as_int(v))); }
__device__ __forceinline__ float wave_sum(float v, int lane) {
#pragma unroll
    for (int o = 1; o < 64; o <<= 1) v += shx(v, o, lane);
    return v;
}
__device__ __forceinline__ float sigmoidf_(float x) { return __builtin_amdgcn_rcpf(1.0f + __expf(-x)); }

#define XB_TMO      128
#define XB_XCNT(j)  (256  + 64 * (j))
#define XB_XSUB(j)  (1280 + 64 * (j))
#define XB_XGEN(j)  (2304 + 64 * (j))
#define XB_TOP      3328
#define XB_TOPGEN   3392
#define XCD_BAR_WORDS 3456
#define XB_SPIN_CAP (1u << 18)
__device__ __forceinline__ unsigned xb_ld(unsigned* p)              { return __hip_atomic_load(p, __ATOMIC_RELAXED, __HIP_MEMORY_SCOPE_AGENT); }
__device__ __forceinline__ unsigned xb_add(unsigned* p, unsigned v) { return __hip_atomic_fetch_add(p, v, __ATOMIC_RELAXED, __HIP_MEMORY_SCOPE_AGENT); }
__device__ __forceinline__ unsigned xb_xcc_id() { return (unsigned)__builtin_amdgcn_s_getreg((3 << 11) | 20) & 0xFu; }
#define XB_SPIN(cond, bar) do { unsigned _sp = 0; while (cond) { __builtin_amdgcn_s_sleep(1); \
    if ((++_sp & 255u) == 0u) { if (xb_ld(&(bar)[XB_TMO])) break; if (_sp > XB_SPIN_CAP) { atomicAdd(&(bar)[XB_TMO], 1u); break; } } } } while (0)
struct XcdBarrier { unsigned* bar; unsigned x; volatile LAS unsigned* st; };
__device__ __forceinline__ XcdBarrier xcd_barrier_post(unsigned* bar, volatile LAS unsigned* st) {
    XcdBarrier b; b.bar = bar; b.x = xb_xcc_id(); b.st = st;
    if (threadIdx.x == 0) (void)xb_add(&bar[XB_XCNT(b.x)], 1u);
    return b;
}
__device__ __forceinline__ void xcd_barrier_complete(unsigned* bar, unsigned x, unsigned& nloc, unsigned& nx) {
    const unsigned G = gridDim.x * gridDim.y * gridDim.z;
    unsigned sum, cnt, mine, sp = 0u;
    for (;;) {
        sum = 0u; cnt = 0u; mine = 0u;
#pragma unroll
        for (unsigned j = 0; j < 16; ++j) { const unsigned c = xb_ld(&bar[XB_XCNT(j)]); sum += c; cnt += (c > 0u) ? 1u : 0u; mine = (j == x) ? c : mine; }
        if (sum == G) break;
        __builtin_amdgcn_s_sleep(1);
        if ((++sp & 255u) == 0u) { if (xb_ld(&bar[XB_TMO])) break; if (sp > XB_SPIN_CAP) { atomicAdd(&bar[XB_TMO], 1u); break; } }
    }
    nloc = mine > 0u ? mine : 1u; nx = cnt > 0u ? cnt : 1u;
}
__device__ __forceinline__ void xcd_barrier(const XcdBarrier& b) {
    asm volatile("s_waitcnt vmcnt(0)" ::: "memory");
    __syncthreads();
    if (threadIdx.x == 0) {
        unsigned* bar = b.bar;
        __builtin_amdgcn_s_waitcnt(0);
        unsigned nloc = b.st[0], nx = b.st[1];
        if (nloc == 0u) { xcd_barrier_complete(bar, b.x, nloc, nx); b.st[0] = nloc; b.st[1] = nx; }
        const unsigned old = xb_add(&bar[XB_XSUB(b.x)], 1u);
        const unsigned gen = old / nloc;
        if (old + 1u == (gen + 1u) * nloc) {
            __builtin_amdgcn_fence(__ATOMIC_RELEASE, "agent");
            asm volatile("s_waitcnt vmcnt(0)" ::: "memory");
            const unsigned og = xb_add(&bar[XB_TOP], 1u);
            const unsigned tg = og / nx;
            if (og + 1u == (tg + 1u) * nx) xb_add(&bar[XB_TOPGEN], 1u);
            else XB_SPIN(xb_ld(&bar[XB_TOPGEN]) == tg, bar);
            __builtin_amdgcn_fence(__ATOMIC_ACQUIRE, "agent");
            xb_add(&bar[XB_XGEN(b.x)], 1u);
            asm volatile("s_waitcnt vmcnt(0)" ::: "memory");
        } else {
            XB_SPIN(xb_ld(&bar[XB_XGEN(b.x)]) == gen, bar);
            __builtin_amdgcn_fence(__ATOMIC_ACQUIRE, "agent");
            asm volatile("s_waitcnt vmcnt(0)" ::: "memory");
        }
    }
    __syncthreads();
}

struct Frame {
    LAS unsigned char* lds;
    volatile LAS unsigned* MISC;
    gu32* ctl;
    unsigned char* ws;
    int tid, lane, wave, vcu, G, gw, NGW;
    const __attribute__((address_space(4))) char* ka; float* out;
};
#define FIN(i) ((const float*)(const __attribute__((address_space(1))) float*)(*(const float* const volatile __attribute__((address_space(4)))*)(F.ka + 8 * (i))))
__device__ __forceinline__ void p0_transpose_item(const float* W, int K, int N, bf16* WT, int row_off, LAS float* scr, int item, int lane) {
    const int nblk = N / 32, kb = item / nblk, nb = item % nblk, k0 = 64 * kb, n0 = 32 * nb;
    const int kr = lane >> 3, nc = 4 * (lane & 7);
    f32x4 v[8];
#pragma unroll
    for (int i = 0; i < 8; ++i) v[i] = *(const GAS f32x4*)(W + (size_t)(k0 + 8 * i + kr) * N + n0 + nc);
#pragma unroll
    for (int i = 0; i < 8; ++i) *(LAS f32x4*)(scr + (8 * i + kr) * 36 + nc) = v[i];
    LDS_WAIT(); asm volatile("" ::: "memory");
    const int c = lane & 7;
#pragma unroll
    for (int j = 0; j < 4; ++j) { const int n = (lane >> 3) + 8 * j; const LAS float* s = scr + (8 * c) * 36 + n;
        v4u o; o.x = pk2(s[0 * 36], s[1 * 36]); o.y = pk2(s[2 * 36], s[3 * 36]); o.z = pk2(s[4 * 36], s[5 * 36]); o.w = pk2(s[6 * 36], s[7 * 36]);
        *(GAS v4u*)(WT + (size_t)(row_off + n0 + n) * K + k0 + 8 * c) = o; }
    LDS_WAIT(); asm volatile("" ::: "memory");
}
__device__ __forceinline__ void ln_row(f32x4 (&v)[4], const float* g, const float* b, int lane) {
    float s = 0.f;
#pragma unroll
    for (int j = 0; j < 4; ++j) s += (v[j].x + v[j].y) + (v[j].z + v[j].w);
    const float mean = wave_sum(s, lane) * (1.f / D); float s2 = 0.f;
#pragma unroll
    for (int j = 0; j < 4; ++j) { v[j] = v[j] - mean; s2 += (v[j].x * v[j].x + v[j].y * v[j].y) + (v[j].z * v[j].z + v[j].w * v[j].w); }
    const float rstd = 1.f / sqrtf(wave_sum(s2, lane) * (1.f / D) + LN_EPS);
#pragma unroll
    for (int j = 0; j < 4; ++j) { const f32x4 gg = *(const f32x4*)(g + 4 * lane + 256 * j), bb = *(const f32x4*)(b + 4 * lane + 256 * j); v[j] = v[j] * rstd * gg + bb; }
}
__device__ __forceinline__ void store_row_bf16(const f32x4 (&v)[4], bf16* orow, int lane) {
    GAS unsigned long long* o8 = (GAS unsigned long long*)orow + lane;
#pragma unroll
    for (int j = 0; j < 4; ++j) o8[64 * j] = (unsigned long long)pk2(v[j].x, v[j].y) | ((unsigned long long)pk2(v[j].z, v[j].w) << 32);
}
__device__ __forceinline__ void load_row_bf16(f32x4 (&v)[4], const bf16* irow, int lane) {
    const GAS unsigned long long* i8 = (const GAS unsigned long long*)irow + lane;
#pragma unroll
    for (int j = 0; j < 4; ++j) { const unsigned long long w = i8[64 * j]; const unsigned lo = (unsigned)w, hi = (unsigned)(w >> 32);
        v[j] = (f32x4){bf2f(lo & 0xffffu), bf2f(lo >> 16), bf2f(hi & 0xffffu), bf2f(hi >> 16)}; }
}

__device__ __forceinline__ void conv_weights(Frame& F, int l) {
    const float* in3 = FIN(3); const float* in12 = FIN(12); const float* in15 = FIN(15); const float* in16 = FIN(16); const float* in17 = FIN(17); const float* in18 = FIN(18); const float* in23 = FIN(23); const float* in24 = FIN(24); const float* in25 = FIN(25);
    LAS float* scr = (LAS float*)(F.lds + F.wave * WAVE_LDS);
    constexpr int I_IN = 16 * 176, I_UA = 4 * 32, I_UC = 8 * 32, I_OUT = 16 * 32, I_GLU = 4 * 8, I_E = 16 * 32;
    constexpr int NITEMS = I_IN + 2 * I_UA + I_UC + I_OUT + I_GLU + 3 * NE * I_E;
    unsigned char* ws = F.ws;
    for (int it = F.gw; it < NITEMS; it += F.NGW) {
        int r = it; const float* W; bf16* WT; int K, N, row_off = 0;
        if (r < I_IN) { W = in3 + (size_t)l * D * INW; K = D; N = INW; WT = (bf16*)(ws + W_IN); }
        else if ((r -= I_IN) < I_UA) { W = in15 + (size_t)l * 256 * D; K = 256; N = D; WT = (bf16*)(ws + W_UPA); }
        else if ((r -= I_UA) < I_UA) { W = in16 + (size_t)l * 256 * D; K = 256; N = D; WT = (bf16*)(ws + W_UPB); }
        else if ((r -= I_UA) < I_UC) { W = in17 + (size_t)l * 512 * D; K = 512; N = D; WT = (bf16*)(ws + W_UPC); }
        else if ((r -= I_UC) < I_OUT) { W = in18 + (size_t)l * D * D; K = D; N = D; WT = (bf16*)(ws + W_OUT); }
        else if ((r -= I_OUT) < I_GLU) { W = in12 + (size_t)l * 256 * 256; K = 256; N = 256; WT = (bf16*)(ws + W_GLU); }
        else { r -= I_GLU; const int which = r / (NE * I_E); r -= which * (NE * I_E); const int e = r / I_E; r -= e * I_E; K = D; N = FF;
            if (which < 2) {
                const int n0 = 32 * (r % 32); row_off = e * 2048 + (n0 / 128) * 256 + (n0 % 128) + which * 128 - n0;
                W = (which == 0 ? in23 : in24) + ((size_t)l * NE + e) * D * FF; WT = (bf16*)(ws + W_13);
            } else { W = in25 + ((size_t)l * NE + e) * FF * D; WT = (bf16*)(ws + W_2); row_off = e * 1024; }
        }
        p0_transpose_item(W, K, N, WT, row_off, scr, r, pg8::launder_i(F.lane));
    }
}
__device__ __forceinline__ void s5_tables(Frame& F, int l) {
    const float* in4 = FIN(4); const float* in5 = FIN(5); const float* in6 = FIN(6); const float* in7 = FIN(7); const float* in8 = FIN(8); const float* in9 = FIN(9); const float* in10 = FIN(10);
    const int gt = blockIdx.x * (NWAVES * 64) + F.tid;
    if (gt < 1024) {
        const int g = gt >> 6, p = gt & 63;
        const double dt = exp((double)in6[l * 16 + g]);
        const double lre = (double)in4[l * 1024 + gt], lim = (double)in5[l * 1024 + gt];
        const double er = exp(lre * dt), lbr = er * cos(lim * dt), lbi = er * sin(lim * dt);
        const double nr = lbr - 1.0, ni = lbi, den = lre * lre + lim * lim;
        const double zr = (nr * lre + ni * lim) / den, zi = (ni * lre - nr * lim) / den;
        bf16* bbar = (bf16*)(F.ws + S5T_BBAR + (size_t)l * S5T_LAYER) + (size_t)g * 128 * 32;
        bf16* cmat = (bf16*)(F.ws + S5T_CMAT + (size_t)l * S5T_LAYER) + (size_t)g * 16 * 128;
        f32x2* lamc = (f32x2*)(F.ws + S5T_LAMC + (size_t)l * S5T_LAYER) + (size_t)gt * 8;
        const int nre = 32 * (p >> 4) + (p & 15), nim = nre + 16;
        const float* bre = in7 + ((size_t)l * 1024 + gt) * 16; const float* bim = in8 + ((size_t)l * 1024 + gt) * 16;
        for (int c = 0; c < 16; ++c) { const double br = bre[c], bi = bim[c];
            bbar[nre * 32 + c] = (bf16)f2bf((float)(br * zr - bi * zi)); bbar[nim * 32 + c] = (bf16)f2bf((float)(br * zi + bi * zr));
            bbar[nre * 32 + 16 + c] = 0; bbar[nim * 32 + 16 + c] = 0; }
        const float* cre = in9 + ((size_t)l * 16 + g) * 16 * 64; const float* cim = in10 + ((size_t)l * 16 + g) * 16 * 64;
        for (int c = 0; c < 16; ++c) { cmat[c * 128 + nre] = (bf16)f2bf(cre[c * 64 + p]); cmat[c * 128 + nim] = (bf16)f2bf(-cim[c * 64 + p]); }
        const int pw[8] = {1, 2, 3, 4, 8, 12, 16, 64};
#pragma unroll
        for (int j = 0; j < 8; ++j) { const double k = (double)pw[j], e = exp(k * lre * dt); lamc[j] = (f32x2){(float)(e * cos(k * lim * dt)), (float)(e * sin(k * lim * dt))}; }
    }
}
__device__ __forceinline__ void rope_table(Frame& F) {
    f32x2* tab = (f32x2*)(F.ws + WS_ROPE);
    const int nthr = F.G * NWAVES * 64;
    for (int i = blockIdx.x * (NWAVES * 64) + F.tid; i < SEQ * 32; i += nthr) {
        const int pos = i >> 5, fi = i & 31;
        const double a = (double)pos * pow(10000.0, -(double)fi / 32.0);
        tab[i] = (f32x2){(float)cos(a), (float)sin(a)};
    }
}
__device__ __forceinline__ void ln0_phase(Frame& F) {
    const float* in0 = FIN(0); const float* in1 = FIN(1); const float* in2 = FIN(2);
    bf16* H = (bf16*)(F.ws + WS_H);
    for (int m = F.gw; m < T; m += F.NGW) {
        const GAS f32x4* xr = (const GAS f32x4*)(in0 + (size_t)m * D) + F.lane;
        f32x4 v[4];
#pragma unroll
        for (int j = 0; j < 4; ++j) v[j] = xr[64 * j];
        ln_row(v, in1, in2, F.lane);
        store_row_bf16(v, H + (size_t)m * D, F.lane);
    }
}
namespace pg8 {
struct EpiStore {
    bf16_t* O; int ldc;
    __device__ __forceinline__ void operator()(const f32x4 (&acc)[2][2][4][2], const Unit& u, int wr, int wc, int fr_, int fq_) const {
        const int fr = launder_i(fr_), fq = launder_i(fq_);
        const int row0 = u.pm * BM + wr * 64 + fr, col0 = u.pn * BM + wc * 32 + 8 * fq;
#pragma unroll
        for (int ai = 0; ai < 2; ++ai)
#pragma unroll
            for (int m = 0; m < 4; ++m) { bf16_t* rowp = O + (size_t)(row0 + ai * HALF + m * 16) * ldc + col0;
#pragma unroll
                for (int bj = 0; bj < 2; ++bj) { const f32x4 v0 = acc[ai][bj][m][0], v1 = acc[ai][bj][m][1];
                    u32x4 w; w.x = cvt_pk_bf16(v0[0], v0[1]); w.y = cvt_pk_bf16(v0[2], v0[3]); w.z = cvt_pk_bf16(v1[0], v1[1]); w.w = cvt_pk_bf16(v1[2], v1[3]);
                    *(u32x4*)(rowp + bj * HALF) = w; } }
    }
};
struct EpiGlu {
    const bf16_t* Y; bf16_t* O; const float* bias;
    __device__ __forceinline__ void operator()(const f32x4 (&acc)[2][2][4][2], const Unit& u, int wr, int wc, int fr_, int fq_) const {
        const int fr = launder_i(fr_), fq = launder_i(fq_);
        const int row0 = u.pm * BM + wr * 64 + fr, col0 = wc * 32 + 8 * fq;
#pragma unroll
        for (int ai = 0; ai < 2; ++ai)
#pragma unroll
            for (int m = 0; m < 4; ++m) { const size_t off = (size_t)(row0 + ai * HALF + m * 16) * 256 + col0;
#pragma unroll
                for (int bj = 0; bj < 2; ++bj) { const u32x4 yw = *(const u32x4*)(Y + off + bj * HALF);
                    const f32x4 a0 = acc[ai][bj][m][0] + *(const f32x4*)(bias + col0 + bj * HALF), a1 = acc[ai][bj][m][1] + *(const f32x4*)(bias + col0 + bj * HALF + 4);
                    const float y0 = bf_lo(yw.x), y1 = bf_hi(yw.x), y2 = bf_lo(yw.y), y3 = bf_hi(yw.y), y4 = bf_lo(yw.z), y5 = bf_hi(yw.z), y6 = bf_lo(yw.w), y7 = bf_hi(yw.w);
                    u32x4 w; w.x = cvt_pk_bf16(y0 * sigmoidf_(a0[0]), y1 * sigmoidf_(a0[1])); w.y = cvt_pk_bf16(y2 * sigmoidf_(a0[2]), y3 * sigmoidf_(a0[3]));
                    w.z = cvt_pk_bf16(y4 * sigmoidf_(a1[0]), y5 * sigmoidf_(a1[1])); w.w = cvt_pk_bf16(y6 * sigmoidf_(a1[2]), y7 * sigmoidf_(a1[3]));
                    *(u32x4*)(O + off + bj * HALF) = w; }
                asm volatile("" ::: "memory"); }
    }
};
struct EpiGate {
    const bf16_t* U; bf16_t* MRG;
    __device__ __forceinline__ void operator()(const f32x4 (&acc)[2][2][4][2], const Unit& u, int wr, int wc, int fr_, int fq_) const {
        const int fr = launder_i(fr_), fq = launder_i(fq_);
        const int br = u.pn >> 2, pc = u.pn & 3;
        const int row0 = u.pm * BM + wr * 64 + fr, col0 = pc * BM + wc * 32 + 8 * fq;
#pragma unroll
        for (int ai = 0; ai < 2; ++ai) {
            u32x4 uw[4][2], pw[4][2];
#pragma unroll
            for (int m = 0; m < 4; ++m)
#pragma unroll
                for (int bj = 0; bj < 2; ++bj) { const size_t r = (size_t)(row0 + ai * HALF + m * 16); const int c = col0 + bj * HALF;
                    uw[m][bj] = *(const u32x4*)(U + r * 3072 + br * 1024 + c);
                    if (br > 0) pw[m][bj] = *(const u32x4*)(MRG + r * 1024 + c); else pw[m][bj] = (u32x4){0u, 0u, 0u, 0u}; }
#pragma unroll
            for (int m = 0; m < 4; ++m)
#pragma unroll
                for (int bj = 0; bj < 2; ++bj) { const size_t r = (size_t)(row0 + ai * HALF + m * 16); const int c = col0 + bj * HALF;
                    const f32x4 a0 = acc[ai][bj][m][0], a1 = acc[ai][bj][m][1]; const u32x4 x = uw[m][bj], q = pw[m][bj];
                    u32x4 w;
                    w.x = cvt_pk_bf16(bf_lo(q.x) + sigmoidf_(a0[0]) * bf_lo(x.x), bf_hi(q.x) + sigmoidf_(a0[1]) * bf_hi(x.x));
                    w.y = cvt_pk_bf16(bf_lo(q.y) + sigmoidf_(a0[2]) * bf_lo(x.y), bf_hi(q.y) + sigmoidf_(a0[3]) * bf_hi(x.y));
                    w.z = cvt_pk_bf16(bf_lo(q.z) + sigmoidf_(a1[0]) * bf_lo(x.z), bf_hi(q.z) + sigmoidf_(a1[1]) * bf_hi(x.z));
                    w.w = cvt_pk_bf16(bf_lo(q.w) + sigmoidf_(a1[2]) * bf_lo(x.w), bf_hi(q.w) + sigmoidf_(a1[3]) * bf_hi(x.w));
                    *(u32x4*)(MRG + r * 1024 + c) = w; }
            asm volatile("" ::: "memory");
        }
    }
};
struct GateOrder {
    int G, vc;
    __device__ __forceinline__ bool next(int i, Unit& u) const {
        const int tr = i / 3, br = i - 3 * tr; const int L = tr * G + vc; if (L >= (T / BM) * 4) return false;
        u.pm = L >> 2; u.pn = br * 4 + (L & 3); u.e = 0; u.pl = 0; u.cnt = 0; return true;
    }
    __device__ __forceinline__ int a_row(const Unit&, int) const { return 0; }
};
struct EpiOut {
    const bf16_t* Hh; bf16_t* Z;
    __device__ __forceinline__ void operator()(const f32x4 (&acc)[2][2][4][2], const Unit& u, int wr, int wc, int fr_, int fq_) const {
        const int fr = launder_i(fr_), fq = launder_i(fq_);
        const int row0 = u.pm * BM + wr * 64 + fr, col0 = u.pn * BM + wc * 32 + 8 * fq;
#pragma unroll
        for (int ai = 0; ai < 2; ++ai) {
            u32x4 hw[4][2];
#pragma unroll
            for (int m = 0; m < 4; ++m)
#pragma unroll
                for (int bj = 0; bj < 2; ++bj) hw[m][bj] = *(const u32x4*)(Hh + (size_t)(row0 + ai * HALF + m * 16) * 1024 + col0 + bj * HALF);
#pragma unroll
            for (int m = 0; m < 4; ++m)
#pragma unroll
                for (int bj = 0; bj < 2; ++bj) { const u32x4 h = hw[m][bj]; const f32x4 a0 = acc[ai][bj][m][0], a1 = acc[ai][bj][m][1];
                    u32x4 w; w.x = cvt_pk_bf16(ALPHA * bf_lo(h.x) + a0[0], ALPHA * bf_hi(h.x) + a0[1]); w.y = cvt_pk_bf16(ALPHA * bf_lo(h.y) + a0[2], ALPHA * bf_hi(h.y) + a0[3]);
                    w.z = cvt_pk_bf16(ALPHA * bf_lo(h.z) + a1[0], ALPHA * bf_hi(h.z) + a1[1]); w.w = cvt_pk_bf16(ALPHA * bf_lo(h.w) + a1[2], ALPHA * bf_hi(h.w) + a1[3]);
                    *(u32x4*)(Z + (size_t)(row0 + ai * HALF + m * 16) * 1024 + col0 + bj * HALF) = w; }
            asm volatile("" ::: "memory");
        }
    }
};
struct MoeOrder {
    volatile PG8_LAS int* tab; const int* list; int NT, G, vc, NP;
    __device__ __forceinline__ bool next(int i, Unit& u) const {
        const int L = i * G + vc; if (L >= NP * NT) return false;
        const int p = L / NT, ct = L - p * NT; int e = 0;
        for (int j = 1; j < 16; ++j) e = (p >= tab[16 + j]) ? j : e;
        u.pm = p; u.e = e; u.pl = p - tab[16 + e]; u.cnt = tab[e]; u.pn = e * NT + ct; return true;
    }
    __device__ __forceinline__ int a_row(const Unit& u, int r) const { const int idx = u.pl * BM + r; return idx < u.cnt ? (list[(size_t)u.e * T + idx] >> 1) : 0; }
};
struct EpiFfn1 {
    bf16_t* HB;
    __device__ __forceinline__ void operator()(const f32x4 (&acc)[2][2][4][2], const Unit& u, int wr, int wc, int fr_, int fq_) const {
        const int fr = launder_i(fr_), fq = launder_i(fq_);
        const int ct = u.pn & 7; const int row0 = u.pm * BM + wr * 64 + fr, col0 = ct * HALF + wc * 32 + 8 * fq;
#pragma unroll
        for (int ai = 0; ai < 2; ++ai)
#pragma unroll
            for (int m = 0; m < 4; ++m) { bf16_t* rowp = HB + (size_t)(row0 + ai * HALF + m * 16) * FF + col0;
                float h[8];
#pragma unroll
                for (int n = 0; n < 2; ++n)
#pragma unroll
                    for (int j = 0; j < 4; ++j) { const float a = acc[ai][0][m][n][j], b = acc[ai][1][m][n][j]; h[4 * n + j] = a * sigmoidf_(a) * b; }
                u32x4 w; w.x = cvt_pk_bf16(h[0], h[1]); w.y = cvt_pk_bf16(h[2], h[3]); w.z = cvt_pk_bf16(h[4], h[5]); w.w = cvt_pk_bf16(h[6], h[7]);
                *(u32x4*)rowp = w; }
    }
};
struct EpiFfn2 {
    const int* list; const float* lgate; bf16_t* YS;
    __device__ __forceinline__ void operator()(const f32x4 (&acc)[2][2][4][2], const Unit& u, int wr, int wc, int fr_, int fq_) const {
        const int fr = launder_i(fr_), fq = launder_i(fq_);
        const int ct = u.pn & 3; const int col0 = ct * BM + wc * 32 + 8 * fq;
        int ent[2][4]; float gt[2][4];
#pragma unroll
        for (int ai = 0; ai < 2; ++ai)
#pragma unroll
            for (int m = 0; m < 4; ++m) { const int idx = u.pl * BM + ai * HALF + wr * 64 + m * 16 + fr; const bool ok = idx < u.cnt;
                ent[ai][m] = ok ? list[(size_t)u.e * T + idx] : -1; gt[ai][m] = ok ? lgate[(size_t)u.e * T + idx] : 0.f; }
#pragma unroll
        for (int ai = 0; ai < 2; ++ai)
#pragma unroll
            for (int m = 0; m < 4; ++m) {
                if (ent[ai][m] >= 0) { bf16_t* rowp = YS + (size_t)ent[ai][m] * 1024 + col0; const float g = gt[ai][m];
#pragma unroll
                    for (int bj = 0; bj < 2; ++bj) { const f32x4 v0 = acc[ai][bj][m][0] * g, v1 = acc[ai][bj][m][1] * g;
                        u32x4 w; w.x = cvt_pk_bf16(v0[0], v0[1]); w.y = cvt_pk_bf16(v0[2], v0[3]); w.z = cvt_pk_bf16(v1[0], v1[1]); w.w = cvt_pk_bf16(v1[2], v1[3]);
                        *(u32x4*)(rowp + bj * HALF) = w; } } }
    }
};
}
__device__ __forceinline__ void ln1_route_phase(Frame& F, int l) {
    const float* in19 = FIN(19); const float* in20 = FIN(20); const float* in21 = FIN(21); const float* in22 = FIN(22);
    const bf16* Z = (const bf16*)(F.ws + WS_R3); bf16* H = (bf16*)(F.ws + WS_H);
    int* bcnt = (int*)(F.ws + WS_BCNT);
    LAS float* rwT = (LAS float*)F.lds;
    LAS int* sel_e = (LAS int*)(F.lds + 65536); LAS float* sel_g = (LAS float*)(F.lds + 65536 + 1024); LAS int* rnk = (LAS int*)(F.lds + 65536 + 2048);
    for (int i = F.tid; i < 16 * 1024; i += NWAVES * 64) { const int k = i >> 4, e = i & 15; rwT[e * 1024 + k] = in21[i]; }
    __syncthreads();
    const float* g1 = in19 + (size_t)l * D; const float* b1 = in20 + (size_t)l * D;
    for (int rb = blockIdx.x; rb < T / 128; rb += F.G) {
        for (int i2 = 0; i2 < 16; i2 += 2) {
            const int tl = F.wave * 16 + i2, m = rb * 128 + tl;
            f32x4 v[2][4];
            load_row_bf16(v[0], Z + (size_t)m * D, F.lane); load_row_bf16(v[1], Z + (size_t)(m + 1) * D, F.lane);
            ln_row(v[0], g1, b1, F.lane); ln_row(v[1], g1, b1, F.lane);
            store_row_bf16(v[0], H + (size_t)m * D, F.lane); store_row_bf16(v[1], H + (size_t)(m + 1) * D, F.lane);
            LAS float* red = (LAS float*)(F.lds + 69632 + F.wave * 8704);
#pragma unroll
            for (int e = 0; e < 16; ++e) { float s0 = 0.f, s1 = 0.f;
#pragma unroll
                for (int j = 0; j < 4; ++j) { const f32x4 w = *(const LAS f32x4*)(rwT + e * 1024 + 4 * F.lane + 256 * j);
                    s0 += (v[0][j].x * w.x + v[0][j].y * w.y) + (v[0][j].z * w.z + v[0][j].w * w.w); s1 += (v[1][j].x * w.x + v[1][j].y * w.y) + (v[1][j].z * w.z + v[1][j].w * w.w); }
                red[e * 64 + F.lane] = s0; red[1088 + e * 64 + F.lane] = s1; }
            asm volatile("s_waitcnt lgkmcnt(0)" ::: "memory");
            const int e0 = F.lane & 15, part = F.lane >> 4; float t0 = 0.f, t1 = 0.f;
#pragma unroll
            for (int c = 0; c < 16; c += 4) { const f32x4 x = *(const LAS f32x4*)(red + e0 * 64 + part * 16 + c), y = *(const LAS f32x4*)(red + 1088 + e0 * 64 + part * 16 + c);
                t0 += (x.x + x.y) + (x.z + x.w); t1 += (y.x + y.y) + (y.z + y.w); }
            t0 += shx(t0, 16, F.lane); t1 += shx(t1, 16, F.lane); t0 += shx(t0, 32, F.lane); t1 += shx(t1, 32, F.lane);
            if (F.lane < 16) { const float rb_ = in22[F.lane]; red[1024 + F.lane] = t0 + rb_; red[1088 + 1024 + F.lane] = t1 + rb_; }
            asm volatile("s_waitcnt lgkmcnt(0)" ::: "memory");
#pragma unroll
            for (int rr = 0; rr < 2; ++rr) {
            float lg[16];
#pragma unroll
            for (int c = 0; c < 16; c += 4) { const f32x4 x = *(const LAS f32x4*)(red + rr * 1088 + 1024 + c); lg[c] = x.x; lg[c + 1] = x.y; lg[c + 2] = x.z; lg[c + 3] = x.w; }
            float mx = lg[0];
#pragma unroll
            for (int e = 1; e < 16; ++e) mx = fmaxf(mx, lg[e]);
            float sum = 0.f;
#pragma unroll
            for (int e = 0; e < 16; ++e) { lg[e] = __expf(lg[e] - mx); sum += lg[e]; }
            const float inv = 1.0f / sum;
#pragma unroll
            for (int e = 0; e < 16; ++e) lg[e] *= inv;
            float gs[4];
#pragma unroll
            for (int q = 0; q < 4; ++q) { const float a = lg[4 * q], b = lg[4 * q + 1], c = lg[4 * q + 2], d = lg[4 * q + 3];
                const float h1 = fmaxf(a, b), l1 = fminf(a, b), h2 = fmaxf(c, d), l2 = fminf(c, d);
                gs[q] = fmaxf(h1, h2) + fmaxf(fminf(h1, h2), fmaxf(l1, l2)); }
            int best = 0; float bv = gs[0];
#pragma unroll
            for (int q = 1; q < 4; ++q) if (gs[q] > bv) { bv = gs[q]; best = q; }
            float s4[4];
#pragma unroll
            for (int j = 0; j < 4; ++j) s4[j] = best == 0 ? lg[j] : best == 1 ? lg[4 + j] : best == 2 ? lg[8 + j] : lg[12 + j];
            int i1 = 0; float v1 = s4[0];
#pragma unroll
            for (int j = 1; j < 4; ++j) if (s4[j] > v1) { v1 = s4[j]; i1 = j; }
            int i2b = -1; float v2 = -1.f;
#pragma unroll
            for (int j = 0; j < 4; ++j) if (j != i1 && s4[j] > v2) { v2 = s4[j]; i2b = j; }
            if (F.lane == 0) { const float den = v1 + v2; const int t2 = tl + rr;
                sel_e[2 * t2] = 4 * best + i1; sel_e[2 * t2 + 1] = 4 * best + i2b; sel_g[2 * t2] = v1 / den; sel_g[2 * t2 + 1] = v2 / den; }
            }
            asm volatile("s_waitcnt lgkmcnt(0)" ::: "memory");
        }
        __syncthreads();
        {
            LAS int* wcnt = (LAS int*)(F.lds + 65536 + 3072);
            int e = -1, myr = 0;
            if (F.wave < 4) { e = sel_e[F.tid];
#pragma unroll
                for (int x = 0; x < 16; ++x) { const unsigned long long mk = __ballot(e == x); if (e == x) myr = __popcll(mk & ((1ull << F.lane) - 1ull)); if (F.lane == 0) wcnt[F.wave * 16 + x] = __popcll(mk); } }
            __syncthreads();
            if (F.wave < 4) { int off = 0; for (int w = 0; w < F.wave; ++w) off += wcnt[w * 16 + e]; rnk[F.tid] = myr + off; }
            if (F.tid < 16) bcnt[rb * 16 + F.tid] = wcnt[F.tid] + wcnt[16 + F.tid] + wcnt[32 + F.tid] + wcnt[48 + F.tid];
        }
        __syncthreads();
    }
}
__device__ __forceinline__ void dispatch_phase(Frame& F) {
    int* list = (int*)(F.ws + WS_LIST); float* lgate = (float*)(F.ws + WS_LIST + 2 * MiB); const int* bcnt = (const int*)(F.ws + WS_BCNT);
    LAS int* sel_e = (LAS int*)(F.lds + 65536); LAS float* sel_g = (LAS float*)(F.lds + 65536 + 1024); LAS int* rnk = (LAS int*)(F.lds + 65536 + 2048); LAS int* ebase = (LAS int*)(F.lds + 65536 + 3072);
    const int rb = blockIdx.x;
    { LAS int* part = (LAS int*)(F.lds + 65536 + 4096);
      const int e = F.tid & 15, jg = F.tid >> 4; int b = 0;
#pragma unroll
      for (int k = 0; k < 8; ++k) { const int j = jg * 8 + k; b += (j < rb) ? bcnt[j * 16 + e] : 0; }
      part[jg * 16 + e] = b;
      __syncthreads();
      if (F.tid < 16) { int t = 0; for (int g2 = 0; g2 < 32; ++g2) t += part[g2 * 16 + F.tid]; ebase[F.tid] = t; } }
    __syncthreads();
    if (F.tid < 256) { const int a = F.tid, e = sel_e[a], pos = ebase[e] + rnk[a];
        list[(size_t)e * T + pos] = 2 * (rb * 128 + (a >> 1)) + (a & 1); lgate[(size_t)e * T + pos] = sel_g[a]; }
    __syncthreads();
}
__device__ __forceinline__ int moe_table(Frame& F, volatile LAS int* tab) {
    const int* bcnt = (const int*)(F.ws + WS_BCNT);
    LAS int* part = (LAS int*)(F.lds + MISC_OFF + 1024);
    { const int e = F.tid & 15, jg = F.tid >> 4; int b = 0;
#pragma unroll
      for (int k = 0; k < 8; ++k) b += bcnt[(jg * 8 + k) * 16 + e];
      part[jg * 16 + e] = b; }
    __syncthreads();
    if (F.tid < 16) { int t = 0; for (int g2 = 0; g2 < 32; ++g2) t += part[g2 * 16 + F.tid]; tab[F.tid] = t; }
    __syncthreads();
    if (F.tid == 0) { int ps = 0; for (int e = 0; e < 16; ++e) { tab[16 + e] = ps; ps += (tab[e] + 255) >> 8; } tab[32] = ps; }
    __syncthreads();
    return tab[32];
}
__device__ __forceinline__ void ln2_phase(Frame& F, int l, bool last) {
    const float* in26 = FIN(26); const float* in27 = FIN(27);
    bf16* H = (bf16*)(F.ws + WS_H); const bf16* YS = (const bf16*)F.out;
    const float* g2 = in26 + (size_t)l * D; const float* b2 = in27 + (size_t)l * D;
    for (int m = F.gw; m < T; m += F.NGW) {
        f32x4 v[4], a[4], b[4];
        load_row_bf16(v, H + (size_t)m * D, F.lane); load_row_bf16(a, YS + (size_t)(2 * m) * D, F.lane); load_row_bf16(b, YS + (size_t)(2 * m + 1) * D, F.lane);
#pragma unroll
        for (int j = 0; j < 4; ++j) v[j] = v[j] * ALPHA + (a[j] + b[j]);
        ln_row(v, g2, b2, F.lane);
        if (last) { GAS f32x4* o = (GAS f32x4*)(F.out + (size_t)m * D) + F.lane;
#pragma unroll
            for (int j = 0; j < 4; ++j) o[64 * j] = v[j]; }
        else store_row_bf16(v, H + (size_t)m * D, F.lane);
    }
}
#define MFMA16(a, b, c) __builtin_amdgcn_mfma_f32_16x16x32_bf16((a), (b), (c), 0, 0, 0)
#define SB0() __builtin_amdgcn_sched_barrier(0)
#define SETTLE1(a) asm volatile("s_nop 15" : "+v"(a))
#define SETTLE2(a, b) asm volatile("s_nop 15" : "+v"(a), "+v"(b))
#define SETTLE4(a, b, c, d) asm volatile("s_nop 15" : "+v"(a), "+v"(b), "+v"(c), "+v"(d))
__device__ __forceinline__ unsigned long long pack4(float a, float b, float c, float d) { return (unsigned long long)pk2(a, b) | ((unsigned long long)pk2(c, d) << 32); SB0(); }
__device__ __forceinline__ float gamma_log2(int h) { return __log2f(1.0f - exp2f(-5.0f - (float)h)); }
union BF8 { bf16x8 v; v4u u; unsigned short s[8]; };

__device__ __forceinline__ void sb_phase(Frame& F) {
    const bf16* P = (const bf16*)(F.ws + WS_R3); bf16* YB = (bf16*)(F.ws + WS_YB);
    LAS bf16* VT = (LAS bf16*)(F.lds + F.wave * WAVE_LDS);
    LAS bf16* Wt = VT + 64 * 40;
    const int lane = pg8::launder_i(F.lane), fr = lane & 15, q = lane >> 4;
    for (int u = F.gw; u < NB * 4 * 512; u += F.NGW) {
        const int qt = u & 511, h = (u >> 9) & 3, b = u >> 11;
        const int t0 = qt * 16, tq = t0 + fr; const size_t rowbase = (size_t)b * SEQ;
        const bf16* qp = P + (rowbase + tq) * PW + C_QB + h * 64 + 8 * q;
        const bf16x8 bq0 = *(const bf16x8*)qp, bq1 = *(const bf16x8*)(qp + 32);
        f32x4 o[4];
#pragma unroll
        for (int i = 0; i < 4; ++i) o[i] = (f32x4){0.f, 0.f, 0.f, 0.f};
        float carry = 0.f;
        for (int jb = t0 >> 5; jb >= 0; --jb) {
            const int kb = jb * 32;
            f32x4 z[2];
            SB0();
#pragma unroll
            for (int i = 0; i < 2; ++i) { const bf16* kp = P + (rowbase + kb + 16 * i + fr) * PW + C_KB + h * 64 + 8 * q;
                const bf16x8 a0 = *(const bf16x8*)kp, a1 = *(const bf16x8*)(kp + 32);
                z[i] = MFMA16(a0, bq0, ((f32x4){0.f, 0.f, 0.f, 0.f})); z[i] = MFMA16(a1, bq1, z[i]); }
            SETTLE2(z[0], z[1]); SB0();
            BF8 vv[4];
#pragma unroll
            for (int pp = 0; pp < 4; ++pp) { const int idx = lane + 64 * pp, key = idx >> 3, dc = idx & 7;
                vv[pp].u = *(const v4u*)(P + (rowbase + kb + key) * PW + C_VB + h * 64 + dc * 8); }
            float lb[2][4], lz[2][4], tot[2];
#pragma unroll
            for (int i = 0; i < 2; ++i) { tot[i] = 0.f;
#pragma unroll
                for (int r = 0; r < 4; ++r) { const int s = kb + 16 * i + 4 * q + r; const float zz = z[i][r] * 0.125f;
                    const float sp = fmaxf(zz, 0.f) + __logf(1.0f + __expf(-fabsf(zz)));
                    lb[i][r] = (s < tq) ? -sp : 0.f; lz[i][r] = zz - sp; tot[i] += lb[i][r]; } }
            float t1[2], t2[2], t3[2];
#pragma unroll
            for (int i = 0; i < 2; ++i) { t1[i] = shx(tot[i], 16, lane); t2[i] = shx(tot[i], 32, lane); t3[i] = shx(tot[i], 48, lane); }
            float above[2] = {0.f, 0.f}, blk = 0.f;
#pragma unroll
            for (int i2 = 0; i2 < 2; ++i2)
#pragma unroll
                for (int qq = 0; qq < 4; ++qq) { const float sg = (qq == q) ? tot[i2] : (qq == (q ^ 1)) ? t1[i2] : (qq == (q ^ 2)) ? t2[i2] : t3[i2];
                    blk += sg;
#pragma unroll
                    for (int i = 0; i < 2; ++i) if (4 * i2 + qq > 4 * i + q) above[i] += sg; }
#pragma unroll
            for (int i = 0; i < 2; ++i) { float w[4]; float suf = 0.f;
#pragma unroll
                for (int r = 3; r >= 0; --r) { const int s = kb + 16 * i + 4 * q + r; const float c = carry + above[i] + suf;
                    w[r] = (s < tq) ? __expf(lz[i][r] + c) : 0.f; suf += lb[i][r]; }
                *(LAS unsigned long long*)(Wt + fr * 40 + 16 * i + 4 * q) = pack4(w[0], w[1], w[2], w[3]); }
#pragma unroll
            for (int pp = 0; pp < 4; ++pp) { const int idx = lane + 64 * pp, key = idx >> 3, dc = idx & 7;
#pragma unroll
                for (int j = 0; j < 8; ++j) VT[(dc * 8 + j) * 40 + key] = vv[pp].s[j]; }
            SB0();
            const bf16x8 bw = *(const LAS bf16x8*)(Wt + fr * 40 + 8 * q);
#pragma unroll
            for (int i = 0; i < 4; ++i) { const bf16x8 a = *(const LAS bf16x8*)(VT + (16 * i + fr) * 40 + 8 * q); o[i] = MFMA16(a, bw, o[i]); }
            SB0();
            carry += blk;
            if (__all(carry < -30.0f)) break;
        }
        SETTLE4(o[0], o[1], o[2], o[3]); SB0();
#pragma unroll
        for (int i = 0; i < 4; ++i) *(GAS unsigned long long*)(YB + (rowbase + tq) * 256 + h * 64 + 16 * i + 4 * q) = pack4(o[i][0], o[i][1], o[i][2], o[i][3]);
    }
}

__device__ __forceinline__ void retA_phase(Frame& F) {
    const bf16* P = (const bf16*)(F.ws + WS_R3); float* KV = (float*)(F.ws + WS_KV); const f32x2* rope = (const f32x2*)(F.ws + WS_ROPE);
    LAS bf16* KT = (LAS bf16*)(F.lds + F.wave * WAVE_LDS);
    LAS bf16* VT = KT + 64 * 72;
    const int lane = pg8::launder_i(F.lane), fr = lane & 15, q = lane >> 4;
    for (int u = F.gw; u < NB * NCH * 4 * 2; u += F.NGW) {
        const int dh = u & 1, h = (u >> 1) & 3, n = (u >> 3) & 127, b = u >> 10;
        const size_t row0 = (size_t)b * SEQ + n * 64; const float l2g = gamma_log2(h);
#pragma unroll
        for (int it = 0; it < 4; ++it) { const int idx = lane + 64 * it, s = idx >> 2, pc = idx & 3;
            const bf16* kp = P + (row0 + s) * PW + C_KC + h * 64 + 8 * pc;
            BF8 lo, hi; lo.u = *(const v4u*)kp; hi.u = *(const v4u*)(kp + 32);
            const f32x4* rt = (const f32x4*)(rope + (size_t)(n * 64 + s) * 32 + 8 * pc);
            const float f = 0.125f * exp2f(l2g * (float)(63 - s));
#pragma unroll
            for (int j2 = 0; j2 < 4; ++j2) { const f32x4 cs = rt[j2];
                { const float t1 = bf2f(lo.s[2 * j2]), t2 = bf2f(hi.s[2 * j2]);
                  KT[(8 * pc + 2 * j2) * 72 + s] = (bf16)f2bf((t1 * cs.x - t2 * cs.y) * f); KT[(32 + 8 * pc + 2 * j2) * 72 + s] = (bf16)f2bf((t1 * cs.y + t2 * cs.x) * f); }
                { const float t1 = bf2f(lo.s[2 * j2 + 1]), t2 = bf2f(hi.s[2 * j2 + 1]);
                  KT[(8 * pc + 2 * j2 + 1) * 72 + s] = (bf16)f2bf((t1 * cs.z - t2 * cs.w) * f); KT[(32 + 8 * pc + 2 * j2 + 1) * 72 + s] = (bf16)f2bf((t1 * cs.w + t2 * cs.z) * f); } } }
#pragma unroll
        for (int it = 0; it < 8; ++it) { const int idx = lane + 64 * it, s = idx >> 3, dc = idx & 7;
            BF8 vv; vv.u = *(const v4u*)(P + (row0 + s) * PW + C_VC + h * 128 + dh * 64 + dc * 8);
#pragma unroll
            for (int j = 0; j < 8; ++j) VT[(dc * 8 + j) * 72 + s] = vv.s[j]; }
        f32x4 acc[4][4];
#pragma unroll
        for (int i = 0; i < 4; ++i)
#pragma unroll
            for (int jt = 0; jt < 4; ++jt) acc[i][jt] = (f32x4){0.f, 0.f, 0.f, 0.f};
        SB0();
#pragma unroll
        for (int ks = 0; ks < 2; ++ks) { bf16x8 bk[4];
#pragma unroll
            for (int jt = 0; jt < 4; ++jt) bk[jt] = *(const LAS bf16x8*)(KT + (16 * jt + fr) * 72 + 8 * q + 32 * ks);
#pragma unroll
            for (int i = 0; i < 4; ++i) { const bf16x8 a = *(const LAS bf16x8*)(VT + (16 * i + fr) * 72 + 8 * q + 32 * ks);
#pragma unroll
                for (int jt = 0; jt < 4; ++jt) acc[i][jt] = MFMA16(a, bk[jt], acc[i][jt]); } }
#pragma unroll
        for (int i = 0; i < 4; ++i) SETTLE4(acc[i][0], acc[i][1], acc[i][2], acc[i][3]); SB0();
        float* dst = KV + ((size_t)(b * NCH + n) * 4 + h) * 8192;
#pragma unroll
        for (int i = 0; i < 4; ++i)
#pragma unroll
            for (int jt = 0; jt < 4; ++jt)
#pragma unroll
                for (int r = 0; r < 4; ++r) dst[(dh * 64 + 16 * i + 4 * q + r) * 64 + 16 * jt + fr] = acc[i][jt][r];
    }
}

__device__ __forceinline__ void scanB_phase(Frame& F, int l) {
    const float* KV = (const float*)(F.ws + WS_KV); bf16* KV2 = (bf16*)F.out; const f32x2* E = (const f32x2*)(F.ws + WS_S5); f32x2* E2 = (f32x2*)(F.out + (size_t)16 * 1048576);
    const f32x2* lamc = (const f32x2*)(F.ws + S5T_LAMC + (size_t)l * S5T_LAYER);
    const int gth = blockIdx.x * (NWAVES * 64) + pg8::launder_i(F.tid), nth = F.G * NWAVES * 64;
    for (int c = gth; c < NB * 4 * 8192; c += nth) {
        const int b = c >> 15, h = (c >> 13) & 3, e = c & 8191; const float cd = exp2f(64.0f * gamma_log2(h));
        const size_t o = ((size_t)(b * NCH) * 4 + h) * 8192 + e; float s = 0.f;
        for (int n0 = 0; n0 < NCH; n0 += 16) { float kv[16];
#pragma unroll
            for (int j = 0; j < 16; ++j) kv[j] = KV[o + (size_t)(n0 + j) * 32768];
#pragma unroll
            for (int j = 0; j < 16; ++j) { KV2[o + (size_t)(n0 + j) * 32768] = (bf16)f2bf(s); s = cd * s + kv[j]; } }
    }
    for (int c = gth; c < NB * 1024; c += nth) {
        const int b = c >> 10, gp = c & 1023; const f32x2 l64 = lamc[gp * 8 + 7];
        const size_t o = (size_t)(b * NCH) * 1024 + gp; f32x2 s = (f32x2){0.f, 0.f};
        for (int n0 = 0; n0 < NCH; n0 += 16) { f32x2 en[16];
#pragma unroll
            for (int j = 0; j < 16; ++j) en[j] = E[o + (size_t)(n0 + j) * 1024];
#pragma unroll
            for (int j = 0; j < 16; ++j) { E2[o + (size_t)(n0 + j) * 1024] = s; s = (f32x2){l64.x * s.x - l64.y * s.y + en[j].x, l64.x * s.y + l64.y * s.x + en[j].y}; } }
    }
}

__device__ __forceinline__ f32x2 cmul(f32x2 a, f32x2 b) { return (f32x2){a.x * b.x - a.y * b.y, a.x * b.y + a.y * b.x}; }
__device__ __forceinline__ f32x2 cfma(f32x2 a, f32x2 b, f32x2 c) { return (f32x2){a.x * b.x - a.y * b.y + c.x, a.x * b.y + a.y * b.x + c.y}; }
template <bool FULL>
__device__ __forceinline__ void s5_phase(Frame& F, int l, size_t e_off = WS_S5) {
    const float* in11 = FIN(11);
    const bf16* P = (const bf16*)(F.ws + WS_R3); f32x2* E = (f32x2*)(F.ws + e_off); bf16* YAP = (bf16*)(F.ws + WS_YAP);
    const bf16* bbar = (const bf16*)(F.ws + S5T_BBAR + (size_t)l * S5T_LAYER); const bf16* cmat = (const bf16*)(F.ws + S5T_CMAT + (size_t)l * S5T_LAYER); const f32x2* lamc = (const f32x2*)(F.ws + S5T_LAMC + (size_t)l * S5T_LAYER);
    LAS bf16* St = (LAS bf16*)(F.lds + F.wave * WAVE_LDS);
    volatile LAS f32x2* Xs = (volatile LAS f32x2*)(F.lds + F.wave * WAVE_LDS + 9216);
    const int lane = pg8::launder_i(F.lane), fr = lane & 15, q = lane >> 4;
    for (int u = F.gw; u < NB * NCH * 16; u += F.NGW) {
        const int g = u & 15, n = (u >> 4) & 127, b = u >> 11;
        const size_t row0 = (size_t)b * SEQ + n * 64;
        bf16x8 ua[4];
#pragma unroll
        for (int it = 0; it < 4; ++it) { BF8 t; t.u = (v4u){0u, 0u, 0u, 0u}; if (q < 2) t.u = *(const v4u*)(P + (row0 + 16 * it + fr) * PW + C_UA + g * 16 + 8 * q); ua[it] = t.v; }
        f32x4 y[4];
#pragma unroll
        for (int it = 0; it < 4; ++it) y[it] = (f32x4){0.f, 0.f, 0.f, 0.f};
#pragma unroll 1
        for (int ip = 0; ip < 4; ++ip) {
            const int p = 16 * ip + fr;
            const bf16x8 bre = *(const bf16x8*)(bbar + ((size_t)g * 128 + 32 * ip + fr) * 32 + 8 * q), bim = *(const bf16x8*)(bbar + ((size_t)g * 128 + 32 * ip + 16 + fr) * 32 + 8 * q);
            const f32x2* lc = lamc + (size_t)(g * 64 + p) * 8;
            const f32x2 L1 = lc[0], L2 = lc[1], L3 = lc[2], L4 = lc[3], L8 = lc[4], L12 = lc[5], L16 = lc[6];
            const f32x2 Lq = q == 0 ? (f32x2){1.f, 0.f} : q == 1 ? L4 : q == 2 ? L8 : L12;
            f32x2 Tin = (f32x2){0.f, 0.f}, dbg = (f32x2){0.f, 0.f};
            if (FULL) Tin = ((const f32x2*)(F.out + (size_t)16 * 1048576))[((size_t)(b * NCH + n) * 16 + g) * 64 + p];
#pragma unroll
            for (int it = 0; it < 4; ++it) {
                SB0(); f32x4 zr = MFMA16(ua[it], bre, ((f32x4){0.f, 0.f, 0.f, 0.f})), zi = MFMA16(ua[it], bim, ((f32x4){0.f, 0.f, 0.f, 0.f}));
                SETTLE2(zr, zi); SB0();
                const f32x2 l0 = (f32x2){zr[0], zi[0]}, l1 = cfma(L1, l0, (f32x2){zr[1], zi[1]}), l2 = cfma(L1, l1, (f32x2){zr[2], zi[2]}), l3 = cfma(L1, l2, (f32x2){zr[3], zi[3]});
                f32x2 x = l3, yv;
#if 0
#define S5X(dst, src) do { Xs[lane] = x; asm volatile("s_waitcnt lgkmcnt(0)" ::: "memory"); dst = Xs[src]; asm volatile("s_waitcnt lgkmcnt(0)" ::: "memory"); } while (0)
                S5X(yv, lane >= 16 ? lane - 16 : lane); if (q >= 1) x = cfma(L4, yv, x);
                S5X(yv, lane >= 32 ? lane - 32 : lane); if (q >= 2) x = cfma(L8, yv, x);
                f32x2 cq; S5X(cq, lane >= 16 ? lane - 16 : lane); if (q == 0) cq = (f32x2){0.f, 0.f};
                f32x2 p3; S5X(p3, 48 + fr);
#else
                yv.x = shup(x.x, 16, lane); yv.y = shup(x.y, 16, lane); if (q >= 1) x = cfma(L4, yv, x);
                yv.x = shup(x.x, 32, lane); yv.y = shup(x.y, 32, lane); if (q >= 2) x = cfma(L8, yv, x);
                f32x2 cq; cq.x = shup(x.x, 16, lane); cq.y = shup(x.y, 16, lane); if (q == 0) cq = (f32x2){0.f, 0.f};
                f32x2 p3; p3.x = shidx(x.x, 48 + fr); p3.y = shidx(x.y, 48 + fr);
#endif
                if (FULL) {
                    const f32x2 base = cfma(Lq, Tin, cq);
                    const f32x2 s0 = cfma(L1, base, l0), s1 = cfma(L2, base, l1), s2 = cfma(L3, base, l2), s3 = cfma(L4, base, l3);
                    LAS bf16* sp = St + (16 * it + 4 * q) * 72 + 32 * (ip & 1) + fr;
                    sp[0] = (bf16)f2bf(s0.x); sp[16] = (bf16)f2bf(s0.y); sp[72] = (bf16)f2bf(s1.x); sp[72 + 16] = (bf16)f2bf(s1.y);
                    sp[144] = (bf16)f2bf(s2.x); sp[144 + 16] = (bf16)f2bf(s2.y); sp[216] = (bf16)f2bf(s3.x); sp[216 + 16] = (bf16)f2bf(s3.y);
                }
                Tin = cfma(L16, Tin, p3);
#if defined(S5V) && S5V == 2
                dbg = (f32x2){L4.x + L8.y + Lq.x, L16.y + L12.x + L2.y + L3.x};
#elif defined(S5V) && S5V == 3
                dbg = p3;
#elif defined(S5V) && S5V == 4
                dbg = cq;
#elif defined(S5V) && S5V == 11
                dbg = (f32x2){zr[0] + zr[1] + zr[2], zi[0] + zi[1] + zi[2]};
#elif defined(S5V) && S5V == 12
                dbg = L1;
#elif defined(S5V) && S5V == 13
                dbg = l1;
#elif defined(S5V) && S5V == 9
                dbg = (f32x2){zr[3], zi[3]};
#elif defined(S5V) && S5V == 10
                dbg = (f32x2){bf2f((unsigned)(unsigned short)ua[it][0]) + bf2f((unsigned)(unsigned short)ua[it][7]), bf2f((unsigned)(unsigned short)bre[0]) + bf2f((unsigned)(unsigned short)bim[7])};
#else
                dbg = l3;
#endif
            }
#if defined(S5V) && S5V >= 1
            if (!FULL) { if (q == (S5V >= 9 ? 3 : S5V >= 6 ? S5V - 5 : 0)) E[((size_t)(b * NCH + n) * 16 + g) * 64 + p] = dbg; }
#else
            if (!FULL) { if (q == 0) E[((size_t)(b * NCH + n) * 16 + g) * 64 + p] = Tin; }
#endif
            if (FULL && (ip & 1)) {
                const int hp = ip >> 1; SB0();
#pragma unroll
                for (int ks = 0; ks < 2; ++ks) { const bf16x8 cb = *(const bf16x8*)(cmat + ((size_t)g * 16 + fr) * 128 + 64 * hp + 8 * q + 32 * ks);
#pragma unroll
                    for (int it = 0; it < 4; ++it) { const bf16x8 a = *(const LAS bf16x8*)(St + (16 * it + fr) * 72 + 8 * q + 32 * ks); y[it] = MFMA16(a, cb, y[it]); } }
                SB0();
            }
        }
        if (FULL) {
            SETTLE4(y[0], y[1], y[2], y[3]); SB0();
            const float dsk = in11[l * 256 + g * 16 + fr];
#pragma unroll
            for (int it = 0; it < 4; ++it)
#pragma unroll
                for (int r = 0; r < 4; ++r) { const size_t row = row0 + 16 * it + 4 * q + r;
                    const float uv = bf2f(P[row * PW + C_UA + g * 16 + fr]); const float v = y[it][r] + dsk * uv;
                    const float a2 = 2.0f * 0.7978845608028654f * (v + 0.044715f * v * v * v); const float th = 1.0f - 2.0f / (__expf(a2) + 1.0f);
                    YAP[row * 256 + g * 16 + fr] = (bf16)f2bf(0.5f * v * (1.0f + th)); }
        }
    }
}

__device__ __forceinline__ void retC_phase(Frame& F, int l) {
    const float* in14 = FIN(14);
    const bf16* P = (const bf16*)(F.ws + WS_R3); const bf16* KVb = (const bf16*)F.out; const f32x2* rope = (const f32x2*)(F.ws + WS_ROPE); bf16* YC = (bf16*)(F.ws + WS_YC);
    LAS bf16* VT = (LAS bf16*)F.lds;
    LAS bf16* KR = (LAS bf16*)(F.lds + 36864);
    LAS bf16* SPT = (LAS bf16*)(F.lds + 55296);
    LAS bf16* Pw = (LAS bf16*)(F.lds + 92160 + F.wave * 2304);
    const int lane = pg8::launder_i(F.lane), fr = lane & 15, q = lane >> 4, tid = F.wave * 64 + lane;
    const float* gn = in14 + (size_t)l * 512;
    for (int pr = blockIdx.x; pr < NB * NCH * 2; pr += F.G) {
        const int hp = pr & 1, n = (pr >> 1) & 127, b = pr >> 8; const size_t row0 = (size_t)b * SEQ + n * 64;
        const int hh = F.wave >> 2, h = 2 * hp + hh, c0 = (F.wave & 3) * 16; const float l2g = gamma_log2(h);
        BF8 vv[4], sp[4], klo, khi, qlo, qhi; f32x4 krt[4], qrt[4];
#pragma unroll
        for (int it = 0; it < 4; ++it) { const int idx = tid + 512 * it, s = idx >> 5, c8 = idx & 31, h2 = c8 >> 4, dv0 = (c8 & 15) * 8;
            vv[it].u = *(const v4u*)(P + (row0 + s) * PW + C_VC + (2 * hp + h2) * 128 + dv0); }
#pragma unroll
        for (int it = 0; it < 4; ++it) { const int idx = tid + 512 * it, h2 = idx >> 10, r = (idx >> 3) & 127, c8 = idx & 7;
            sp[it].u = *(const v4u*)(KVb + ((size_t)(b * NCH + n) * 4 + 2 * hp + h2) * 8192 + r * 64 + c8 * 8); }
        const int kh = tid >> 8, ks_ = (tid >> 2) & 63, kpc = tid & 3;
        { const bf16* kp = P + (row0 + ks_) * PW + C_KC + (2 * hp + kh) * 64 + 8 * kpc; klo.u = *(const v4u*)kp; khi.u = *(const v4u*)(kp + 32);
          const f32x4* rt = (const f32x4*)(rope + (size_t)(n * 64 + ks_) * 32 + 8 * kpc);
#pragma unroll
          for (int j = 0; j < 4; ++j) krt[j] = rt[j]; }
        { const bf16* qp = P + (row0 + c0 + fr) * PW + C_QC + h * 64 + 8 * q; qlo.u = *(const v4u*)qp; qhi.u = *(const v4u*)(qp + 32);
          const f32x4* rt = (const f32x4*)(rope + (size_t)(n * 64 + c0 + fr) * 32 + 8 * q);
#pragma unroll
          for (int j = 0; j < 4; ++j) qrt[j] = rt[j]; }
        const size_t row = row0 + c0 + fr;
        unsigned long long gw8[8]; f32x4 gg8[8];
#pragma unroll
        for (int i = 0; i < 8; ++i) { const int dv = h * 128 + 16 * i + 4 * q; gw8[i] = *(const GAS unsigned long long*)(P + row * PW + C_GC + dv); gg8[i] = *(const f32x4*)(gn + dv); }
#pragma unroll
        for (int it = 0; it < 4; ++it) { const int idx = tid + 512 * it, s = idx >> 5, c8 = idx & 31, h2 = c8 >> 4, dv0 = (c8 & 15) * 8;
#pragma unroll
            for (int j = 0; j < 8; ++j) VT[(h2 * 128 + dv0 + j) * 72 + s] = vv[it].s[j]; }
#pragma unroll
        for (int it = 0; it < 4; ++it) { const int idx = tid + 512 * it, h2 = idx >> 10, r = (idx >> 3) & 127, c8 = idx & 7;
            *(LAS v4u*)(SPT + (h2 * 128 + r) * 72 + c8 * 8) = sp[it].u; }
        { BF8 o0, o1;
#pragma unroll
          for (int j2 = 0; j2 < 4; ++j2) { const f32x4 cs = krt[j2];
              { const float t1 = bf2f(klo.s[2 * j2]), t2 = bf2f(khi.s[2 * j2]); o0.s[2 * j2] = (bf16)f2bf((t1 * cs.x - t2 * cs.y) * 0.125f); o1.s[2 * j2] = (bf16)f2bf((t1 * cs.y + t2 * cs.x) * 0.125f); }
              { const float t1 = bf2f(klo.s[2 * j2 + 1]), t2 = bf2f(khi.s[2 * j2 + 1]); o0.s[2 * j2 + 1] = (bf16)f2bf((t1 * cs.z - t2 * cs.w) * 0.125f); o1.s[2 * j2 + 1] = (bf16)f2bf((t1 * cs.w + t2 * cs.z) * 0.125f); } }
          *(LAS v4u*)(KR + (kh * 64 + ks_) * 72 + 8 * kpc) = o0.u; *(LAS v4u*)(KR + (kh * 64 + ks_) * 72 + 32 + 8 * kpc) = o1.u; }
        bf16x8 qf0, qf1;
        { BF8 o0, o1;
#pragma unroll
          for (int j2 = 0; j2 < 4; ++j2) { const f32x4 cs = qrt[j2];
              { const float t1 = bf2f(qlo.s[2 * j2]), t2 = bf2f(qhi.s[2 * j2]); o0.s[2 * j2] = (bf16)f2bf(t1 * cs.x - t2 * cs.y); o1.s[2 * j2] = (bf16)f2bf(t1 * cs.y + t2 * cs.x); }
              { const float t1 = bf2f(qlo.s[2 * j2 + 1]), t2 = bf2f(qhi.s[2 * j2 + 1]); o0.s[2 * j2 + 1] = (bf16)f2bf(t1 * cs.z - t2 * cs.w); o1.s[2 * j2 + 1] = (bf16)f2bf(t1 * cs.w + t2 * cs.z); } }
          qf0 = o0.v; qf1 = o1.v; }
        __syncthreads();
#pragma unroll
        for (int jt = 0; jt < 4; ++jt) {
            const bf16x8 kf0 = *(const LAS bf16x8*)(KR + (hh * 64 + 16 * jt + fr) * 72 + 8 * q), kf1 = *(const LAS bf16x8*)(KR + (hh * 64 + 16 * jt + fr) * 72 + 32 + 8 * q);
            SB0(); f32x4 sa = MFMA16(qf0, kf0, ((f32x4){0.f, 0.f, 0.f, 0.f})); sa = MFMA16(qf1, kf1, sa);
            SETTLE1(sa); SB0();
#pragma unroll
            for (int r = 0; r < 4; ++r) { const int c = c0 + 4 * q + r, s = 16 * jt + fr; const float dd = (float)(c > s ? c - s : s - c);
                Pw[(4 * q + r) * 72 + 16 * jt + fr] = (bf16)f2bf(sa[r] * exp2f(l2g * dd)); }
        }
        f32x4 o[8];
#pragma unroll
        for (int i = 0; i < 8; ++i) o[i] = (f32x4){0.f, 0.f, 0.f, 0.f};
        SB0();
#pragma unroll
        for (int i = 0; i < 8; ++i)
#pragma unroll
            for (int ks = 0; ks < 2; ++ks) { const bf16x8 a = *(const LAS bf16x8*)(SPT + (hh * 128 + 16 * i + fr) * 72 + 8 * q + 32 * ks); o[i] = MFMA16(a, ks == 0 ? qf0 : qf1, o[i]); }
        SETTLE4(o[0], o[1], o[2], o[3]); SB0(); SETTLE4(o[4], o[5], o[6], o[7]); SB0();
        const float qd = exp2f(l2g * (float)(c0 + fr + 1));
#pragma unroll
        for (int i = 0; i < 8; ++i) o[i] = o[i] * qd;
        SB0();
#pragma unroll
        for (int ks = 0; ks < 2; ++ks) { const bf16x8 bw = *(const LAS bf16x8*)(Pw + fr * 72 + 8 * q + 32 * ks);
#pragma unroll
            for (int i = 0; i < 8; ++i) { const bf16x8 a = *(const LAS bf16x8*)(VT + (hh * 128 + 16 * i + fr) * 72 + 8 * q + 32 * ks); o[i] = MFMA16(a, bw, o[i]); } }
        SETTLE4(o[0], o[1], o[2], o[3]); SB0(); SETTLE4(o[4], o[5], o[6], o[7]); SB0();
        float sm = 0.f;
#pragma unroll
        for (int i = 0; i < 8; ++i) sm += (o[i][0] + o[i][1]) + (o[i][2] + o[i][3]);
        sm += shx(sm, 16, lane); sm += shx(sm, 32, lane);
        const float mean = sm * (1.0f / 128.0f); float vs = 0.f;
#pragma unroll
        for (int i = 0; i < 8; ++i) { o[i] = o[i] - mean; vs += (o[i][0] * o[i][0] + o[i][1] * o[i][1]) + (o[i][2] * o[i][2] + o[i][3] * o[i][3]); }
        vs += shx(vs, 16, lane); vs += shx(vs, 32, lane);
        const float rstd = 1.0f / sqrtf(vs * (1.0f / 128.0f) + LN_EPS);
#pragma unroll
        for (int i = 0; i < 8; ++i) { const int dv = h * 128 + 16 * i + 4 * q; const unsigned long long gw = gw8[i]; const f32x4 gg = gg8[i];
            const float g0 = bf2f((unsigned)gw & 0xffffu), g1 = bf2f(((unsigned)gw) >> 16), g2 = bf2f((unsigned)(gw >> 32) & 0xffffu), g3 = bf2f((unsigned)(gw >> 48));
            *(GAS unsigned long long*)(YC + row * 512 + dv) = pack4(o[i][0] * rstd * gg.x * g0 * sigmoidf_(g0), o[i][1] * rstd * gg.y * g1 * sigmoidf_(g1),
                                                                   o[i][2] * rstd * gg.z * g2 * sigmoidf_(g2), o[i][3] * rstd * gg.w * g3 * sigmoidf_(g3)); }
        __syncthreads();
    }
}
#ifndef DIAG
#define DIAG 0
#endif
#ifndef N_LAUNCH
#define N_LAUNCH 1
#endif
__device__ __forceinline__ void diag_max(Frame& F, float m) {
    if (!(m == m)) m = 3.0e38f;
#pragma unroll
    for (int o = 1; o < 64; o <<= 1) m = fmaxf(m, shx(m, o, F.lane));
    if (F.lane == 0) atomicMax((unsigned*)F.ctl + CW_DIAG, __float_as_uint(m));
}
__device__ __forceinline__ void diag_emit(Frame& F) {
    const float m = __uint_as_float(__hip_atomic_load((unsigned*)F.ctl + CW_DIAG, RLX_AGENT));
    const float v = sqrtf(5.0f * (log10f(fminf(fmaxf(m, 1e-11f), 1e8f)) + 12.0f));
    const size_t n = (size_t)T * D, nth = (size_t)F.G * NWAVES * 64;
    for (size_t i = (size_t)blockIdx.x * (NWAVES * 64) + F.tid; i < n; i += nth) F.out[i] = v;
}
__device__ __forceinline__ unsigned hash_u(unsigned x) { x ^= x >> 16; x *= 0x7feb352du; x ^= x >> 15; x *= 0x846ca68bu; x ^= x >> 16; return x; }
__device__ __forceinline__ void diag_proj(Frame& F) {
    const float* in0 = FIN(0); const float* in1 = FIN(1); const float* in2 = FIN(2); const float* in3 = FIN(3);
    const bf16* P = (const bf16*)(F.ws + WS_R3); float worst = 0.f;
    for (int smp = F.gw; smp < 4096; smp += F.NGW) {
        const int row = hash_u(smp * 2 + 1) % T, col = hash_u(smp * 2 + 2) % PW;
        const GAS f32x4* xr = (const GAS f32x4*)(in0 + (size_t)row * D) + F.lane; f32x4 v[4];
#pragma unroll
        for (int j = 0; j < 4; ++j) v[j] = xr[64 * j];
        ln_row(v, in1, in2, F.lane);
        float s = 0.f;
#pragma unroll
        for (int j = 0; j < 4; ++j) { const int k = 4 * F.lane + 256 * j; const float* w = in3 + (size_t)k * INW + col; s += v[j].x * w[0] + v[j].y * w[INW] + v[j].z * w[2 * INW] + v[j].w * w[3 * INW]; }
        s = wave_sum(s, F.lane);
        worst = fmaxf(worst, fabsf(s - bf2f(P[(size_t)row * PW + col])));
    }
    diag_max(F, worst);
}


__device__ __forceinline__ void emit_frac(Frame& F, const bf16* src, size_t o0, size_t n) {
    const size_t nth = (size_t)F.G * NWAVES * 64;
    for (size_t i = (size_t)blockIdx.x * (NWAVES * 64) + F.tid; i < n; i += nth) { const float x = bf2f(src[i]) * 257.3f; F.out[o0 + i] = x - floorf(x); }
}
#if DIAG >= 2 && DIAG <= 5
__device__ __forceinline__ float diag_sb(Frame& F) {
    const bf16* P = (const bf16*)(F.ws + WS_R3); const bf16* YB = (const bf16*)(F.ws + WS_YB); float worst = 0.f; const int d = F.lane;
    for (int smp = F.gw; smp < 2048; smp += F.NGW) {
        const int b = hash_u(smp * 3 + 1) & 3, h = hash_u(smp * 3 + 2) & 3; int t = hash_u(smp * 3 + 3) % SEQ; if ((smp & 7) == 0) t = smp >> 3 & 63;
        const size_t rb = (size_t)b * SEQ; const float qd = bf2f(P[(rb + t) * PW + C_QB + h * 64 + d]);
        float out = 0.f, cs = 0.f;
        for (int s = t - 1; s >= 0; --s) { const float z = wave_sum(qd * bf2f(P[(rb + s) * PW + C_KB + h * 64 + d])) * 0.125f;
            const float sp = fmaxf(z, 0.f) + log1pf(expf(-fabsf(z)));
            out += expf(z - sp + cs) * bf2f(P[(rb + s) * PW + C_VB + h * 64 + d]); cs -= sp; if (cs < -100.f) break; }
        worst = fmaxf(worst, fabsf(out - bf2f(YB[(rb + t) * 256 + h * 64 + d])));
    }
    return worst;
}
__device__ __forceinline__ float diag_ret(Frame& F, int l) {
    const float* in14 = FIN(14);
    const bf16* P = (const bf16*)(F.ws + WS_R3); const bf16* YC = (const bf16*)(F.ws + WS_YC); float worst = 0.f; const int d = F.lane, fi = d & 31;
    const float invf = powf(10000.0f, -(float)fi / 32.0f);
    for (int smp = F.gw; smp < 1024; smp += F.NGW) {
        const int b = hash_u(smp * 3 + 11) & 3, h = hash_u(smp * 3 + 12) & 3; const int t = hash_u(smp * 3 + 13) % 1536;
        const size_t rb = (size_t)b * SEQ; const float gam = 1.0f - exp2f(-5.0f - (float)h), lg = logf(gam);
        float sn, cs; sincosf((float)t * invf, &sn, &cs);
        const float q1 = bf2f(P[(rb + t) * PW + C_QC + h * 64 + fi]), q2 = bf2f(P[(rb + t) * PW + C_QC + h * 64 + 32 + fi]);
        const float qr = d < 32 ? q1 * cs - q2 * sn : q1 * sn + q2 * cs;
        float o0 = 0.f, o1 = 0.f; const int pend = (t / 64) * 64 + 63;
        for (int ps = 0; ps <= pend; ++ps) { float s2, c2; sincosf((float)ps * invf, &s2, &c2);
            const float k1 = bf2f(P[(rb + ps) * PW + C_KC + h * 64 + fi]), k2 = bf2f(P[(rb + ps) * PW + C_KC + h * 64 + 32 + fi]);
            const float kr = (d < 32 ? k1 * c2 - k2 * s2 : k1 * s2 + k2 * c2) * 0.125f;
            const float sc = wave_sum(qr * kr, F.lane) * expf(lg * fabsf((float)(t - ps)));
            o0 += sc * bf2f(P[(rb + ps) * PW + C_VC + h * 128 + d]); o1 += sc * bf2f(P[(rb + ps) * PW + C_VC + h * 128 + 64 + d]); }
        const float mean = wave_sum(o0 + o1, F.lane) * (1.f / 128.f); const float a0 = o0 - mean, a1 = o1 - mean;
        const float rstd = 1.f / sqrtf(wave_sum(a0 * a0 + a1 * a1, F.lane) * (1.f / 128.f) + LN_EPS);
        const float g0 = bf2f(P[(rb + t) * PW + C_GC + h * 128 + d]), g1 = bf2f(P[(rb + t) * PW + C_GC + h * 128 + 64 + d]);
        const float r0 = a0 * rstd * in14[l * 512 + h * 128 + d] * g0 * sigmoidf_(g0), r1 = a1 * rstd * in14[l * 512 + h * 128 + 64 + d] * g1 * sigmoidf_(g1);
        worst = fmaxf(worst, fmaxf(fabsf(r0 - bf2f(YC[(rb + t) * 512 + h * 128 + d])), fabsf(r1 - bf2f(YC[(rb + t) * 512 + h * 128 + 64 + d]))));
    }
    return worst;
}
__device__ __forceinline__ float diag_s5(Frame& F, int l) {
    const float* in4 = FIN(4); const float* in5 = FIN(5); const float* in6 = FIN(6); const float* in7 = FIN(7); const float* in8 = FIN(8); const float* in9 = FIN(9); const float* in10 = FIN(10); const float* in11 = FIN(11);
    const bf16* P = (const bf16*)(F.ws + WS_R3); const bf16* YAP = (const bf16*)(F.ws + WS_YAP); float worst = 0.f; const int p = F.lane;
    for (int smp = F.gw; smp < 1024; smp += F.NGW) {
        const int b = hash_u(smp * 3 + 21) & 3, g = hash_u(smp * 3 + 22) & 15; const int t = hash_u(smp * 3 + 23) % 1024;
        const size_t rb = (size_t)b * SEQ; const int gp = l * 1024 + g * 64 + p;
        const float dt = expf(in6[l * 16 + g]), lre = in4[gp], lim = in5[gp];
        const float er = expf(lre * dt), lbr = er * cosf(lim * dt), lbi = er * sinf(lim * dt);
        const float nr = lbr - 1.f, ni = lbi, den = lre * lre + lim * lim, zr = (nr * lre + ni * lim) / den, zi = (ni * lre - nr * lim) / den;
        float sr = 0.f, si = 0.f;
        for (int ps = 0; ps <= t; ++ps) { float br = 0.f, bi = 0.f;
            for (int c = 0; c < 16; ++c) { const float uv = bf2f(P[(rb + ps) * PW + C_UA + g * 16 + c]); const float b_r = in7[(size_t)gp * 16 + c], b_i = in8[(size_t)gp * 16 + c];
                br += (b_r * zr - b_i * zi) * uv; bi += (b_r * zi + b_i * zr) * uv; }
            const float nsr = lbr * sr - lbi * si + br, nsi = lbr * si + lbi * sr + bi; sr = nsr; si = nsi; }
        for (int c = 0; c < 16; ++c) { const float cr = in9[((size_t)(l * 16 + g) * 16 + c) * 64 + p], ci = in10[((size_t)(l * 16 + g) * 16 + c) * 64 + p];
            float v = wave_sum(cr * sr - ci * si, F.lane) + in11[l * 256 + g * 16 + c] * bf2f(P[(rb + t) * PW + C_UA + g * 16 + c]);
            v = 0.5f * v * (1.0f + tanhf(0.7978845608028654f * (v + 0.044715f * v * v * v)));
            worst = fmaxf(worst, fabsf(v - bf2f(YAP[(rb + t) * 256 + g * 16 + c]))); }
    }
    return worst;
}
#endif
#ifndef DISABLE
#define DISABLE 0
#endif
#ifndef REPMASK
#define REPMASK 0
#endif
struct Args { const float* in[28]; float* out; unsigned char* ws; int ph_lo, ph_hi; };
__device__ __forceinline__ bool rep_prologue(Frame& F, const XcdBarrier& bar, int rep) { if (rep) xcd_barrier(bar); F.lane = pg8::lane_id_opaque(); F.tid = F.wave * 64 + F.lane; F.ws = pg8::launder_p(F.ws); F.ctl = (gu32*)F.ws; F.out = pg8::launder_p(F.out); return true; }
constexpr int PH_PER_LAYER = 14, N_PHASES = NLAYER * PH_PER_LAYER;
__global__ void __launch_bounds__(NWAVES * 64, 2) hse_fwd(Args args) {
    extern __shared__ __attribute__((aligned(16))) unsigned char lds_raw[];
    Frame F;
    F.lds = (LAS unsigned char*)lds_raw;
    F.MISC = (volatile LAS unsigned*)(F.lds + MISC_OFF);
    F.tid = threadIdx.x; F.lane = F.tid & 63; F.wave = __builtin_amdgcn_readfirstlane(F.tid >> 6);
    F.G = gridDim.x; { const int bx = blockIdx.x; F.vcu = (F.G % 8 == 0) ? (bx % 8) * (F.G / 8) + bx / 8 : bx; }
    F.gw = blockIdx.x * NWAVES + F.wave; F.NGW = F.G * NWAVES;
    F.ws = args.ws; F.ctl = (gu32*)(args.ws + WS_CTL); F.out = args.out;
    F.ka = (const __attribute__((address_space(4))) char*)__builtin_amdgcn_kernarg_segment_ptr();
    for (int u = F.tid; u < (LDS_BYTES - MISC_OFF) / 4; u += NWAVES * 64) ((LAS unsigned*)(F.lds + MISC_OFF))[u] = 0u;
    __syncthreads();
    XcdBarrier bar = xcd_barrier_post((unsigned*)(F.ctl + CW_BAR), F.MISC + 8);
    const int lo = args.ph_lo, hi = args.ph_hi;
#define IN(k) (lo <= (k) && (k) < hi)
#define RELAUNDER() do { F.lane = pg8::lane_id_opaque(); F.tid = F.wave * 64 + F.lane; F.ws = pg8::launder_p(F.ws); F.ctl = (gu32*)F.ws; F.out = pg8::launder_p(F.out); } while (0)
#define SEAM(k) do { if (IN(k) && IN((k) + 1)) xcd_barrier(bar); RELAUNDER(); } while (0)
    PG8_LAS unsigned char* ring = (PG8_LAS unsigned char*)F.lds;
    typedef pg8::bf16_t b16;
    if (IN(0)) { rope_table(F); s5_tables(F, 0); s5_tables(F, 1); ln0_phase(F); }
#ifdef ZERO_E
    { unsigned* Ez = (unsigned*)(F.ws + WS_S5); for (size_t i = (size_t)blockIdx.x * (NWAVES * 64) + F.tid; i < (size_t)NB * NCH * 2048; i += (size_t)F.G * NWAVES * 64) Ez[i] = 0x7fc00000u; }
#endif
#pragma unroll 1
    for (int l = 0; l < NLAYER; ++l) {
        const int pb = l * PH_PER_LAYER; RELAUNDER();
        for (int rep = 0; rep <= ((REPMASK >> 0) & 1); ++rep) if (rep_prologue(F, bar, rep)) if (!((DISABLE >> 0) & 1) && IN(pb + 0)) conv_weights(F, l);
#if DIAG == 30
        if (l == 0) { xcd_barrier(bar); { const size_t n = (size_t)T * D, nth = (size_t)F.G * NWAVES * 64; const float* Ef = (const float*)(F.ws + S5T_LAMC); const bf16* Bb = (const bf16*)(F.ws + S5T_BBAR);
            for (size_t i = (size_t)blockIdx.x * (NWAVES * 64) + F.tid; i < n; i += nth) { float v = 0.f; if (i < 16384) { const float x = Ef[i] * 1000.0f; v = x - floorf(x); } else if (i < 16384 + 98304) { const float x = bf2f(Bb[i - 16384]) * 257.3f; v = x - floorf(x); } F.out[i] = v; } } return; }
#endif
        SEAM(pb + 0);
        for (int rep = 0; rep <= ((REPMASK >> 1) & 1); ++rep) if (rep_prologue(F, bar, rep)) if (!((DISABLE >> 1) & 1) && IN(pb + 1)) { pg8::Gemm g{(const b16*)(F.ws + WS_H), (const b16*)(F.ws + W_IN), D}; pg8::StaticOrder S; S.init(T, PW, F.G, (int)blockIdx.x);
            pg8::EpiStore E{(b16*)(F.ws + WS_R3), PW}; pg8::gemm_phase<pg8::EpiStore, pg8::StaticOrder>(ring, g, S, E, F.wave); }
#if DIAG == 1
        if (l == 0) { xcd_barrier(bar); diag_proj(F); xcd_barrier(bar); diag_emit(F); return; }
#endif
#if DIAG == 32
        if (l == 0) { xcd_barrier(bar); { const size_t n = (size_t)T * D, nth = (size_t)F.G * NWAVES * 64; const bf16* Pp = (const bf16*)(F.ws + WS_R3);
            for (size_t i = (size_t)blockIdx.x * (NWAVES * 64) + F.tid; i < n; i += nth) { const size_t r = i >> 10, c = i & 1023; float v = 0.f; if (c < 256) { const float x = bf2f(Pp[r * PW + c]) * 257.3f; v = x - floorf(x); } F.out[i] = v; } } return; }
#endif
#if DIAG == 20
        if (l == 0) { xcd_barrier(bar); emit_frac(F, (const bf16*)(F.ws + WS_R3), 0, (size_t)T * D); return; }
#endif
        SEAM(pb + 1);
        for (int rep = 0; rep <= ((REPMASK >> 2) & 1); ++rep) if (rep_prologue(F, bar, rep)) if (!((DISABLE >> 2) & 1) && IN(pb + 2)) { s5_phase<false>(F, l); retA_phase(F); sb_phase(F); }
#if DIAG == 31
        if (l == 0) { xcd_barrier(bar); s5_phase<false>(F, l, WS_KV); xcd_barrier(bar);
            { const unsigned* A = (const unsigned*)(F.ws + WS_S5); const unsigned* B = (const unsigned*)(F.ws + WS_KV); float cnt = 0.f; const size_t nth = (size_t)F.G * NWAVES * 64;
              for (size_t i = (size_t)blockIdx.x * (NWAVES * 64) + F.tid; i < (size_t)NB * NCH * 2048; i += nth) cnt += (A[i] != B[i]) ? 1.0f : 0.0f;
              cnt = wave_sum(cnt, F.lane); if (F.lane == 0 && cnt > 0.f) atomicAdd((float*)F.ctl + CW_DIAG, cnt); }
            xcd_barrier(bar); diag_emit(F); return; }
#endif
#if DIAG == 28
        if (l == 0) { xcd_barrier(bar); { const size_t n = (size_t)T * D, nth = (size_t)F.G * NWAVES * 64; const float* Ef = (const float*)(F.ws + WS_S5);
            for (size_t i = (size_t)blockIdx.x * (NWAVES * 64) + F.tid; i < n; i += nth) { float v = 0.f; if (i < (size_t)NB * NCH * 2048) { const float x = Ef[i] * 1000.0f; v = x - floorf(x); } F.out[i] = v; } } return; }
#endif
        SEAM(pb + 2);
        for (int rep = 0; rep <= ((REPMASK >> 3) & 1); ++rep) if (rep_prologue(F, bar, rep)) if (!((DISABLE >> 3) & 1) && IN(pb + 3)) scanB_phase(F, l);
#if DIAG == 29
        if (l == 0) { xcd_barrier(bar); { const size_t n = (size_t)T * D, nth = (size_t)F.G * NWAVES * 64; const float* Ef = (const float*)(F.ws + WS_S5);
            for (size_t i = (size_t)blockIdx.x * (NWAVES * 64) + F.tid; i < n; i += nth) { float v = 0.f; if (i < (size_t)NB * NCH * 2048) { const float x = Ef[i] * 1000.0f; v = x - floorf(x); } F.out[i] = v; } } return; }
#endif
        SEAM(pb + 3);
        for (int rep = 0; rep <= ((REPMASK >> 4) & 1); ++rep) if (rep_prologue(F, bar, rep)) if (!((DISABLE >> 4) & 1) && IN(pb + 4)) { s5_phase<true>(F, l); __syncthreads(); retC_phase(F, l); }
#if DIAG >= 2 && DIAG <= 5
        if (l == 0) { xcd_barrier(bar); float m = 0.f;
            if (DIAG == 2 || DIAG == 3) m = fmaxf(m, diag_s5(F, l));
            if (DIAG == 2 || DIAG == 4) m = fmaxf(m, diag_sb(F));
            if (DIAG == 2 || DIAG == 5) m = fmaxf(m, diag_ret(F, l));
            diag_max(F, m); xcd_barrier(bar); diag_emit(F); return; }
#endif
#if DIAG >= 25 && DIAG <= 27
        if (l == 0) { xcd_barrier(bar); { const size_t n = (size_t)T * D, nth = (size_t)F.G * NWAVES * 64; for (size_t i = (size_t)blockIdx.x * (NWAVES * 64) + F.tid; i < n; i += nth) F.out[i] = 0.f; } xcd_barrier(bar);
            if (DIAG == 25) emit_frac(F, (const bf16*)(F.ws + WS_YC), 0, (size_t)T * 512); if (DIAG == 26) emit_frac(F, (const bf16*)(F.ws + WS_YAP), 0, (size_t)T * 256); if (DIAG == 27) emit_frac(F, (const bf16*)(F.ws + WS_YB), 0, (size_t)T * 256); return; }
#endif
#if DIAG == 21
        if (l == 0) { xcd_barrier(bar); emit_frac(F, (const bf16*)(F.ws + WS_YC), 0, (size_t)T * 512); emit_frac(F, (const bf16*)(F.ws + WS_YAP), (size_t)T * 512, (size_t)T * 256); emit_frac(F, (const bf16*)(F.ws + WS_YB), (size_t)T * 768, (size_t)T * 256); return; }
#endif
        SEAM(pb + 4);
        for (int rep = 0; rep <= ((REPMASK >> 5) & 1); ++rep) if (rep_prologue(F, bar, rep)) if (!((DISABLE >> 5) & 1) && IN(pb + 5)) { pg8::Gemm g{(const b16*)(F.ws + WS_YAP), (const b16*)(F.ws + W_GLU), 256}; pg8::StaticOrder S; S.init(T, 256, F.G, (int)blockIdx.x);
            pg8::EpiGlu E{(const b16*)(F.ws + WS_YAP), (b16*)(F.ws + WS_YA), FIN(13) + (size_t)l * 256}; pg8::gemm_phase<pg8::EpiGlu, pg8::StaticOrder>(ring, g, S, E, F.wave); }
        SEAM(pb + 5);
        for (int rep = 0; rep <= ((REPMASK >> 6) & 1); ++rep) if (rep_prologue(F, bar, rep)) if (!((DISABLE >> 6) & 1) && IN(pb + 6)) {
            { pg8::Gemm g{(const b16*)(F.ws + WS_YA), (const b16*)(F.ws + W_UPA), 256}; pg8::StaticOrder S; S.init(T, D, F.G, (int)blockIdx.x); pg8::EpiStore E{(b16*)(F.ws + WS_R3), 3072}; pg8::gemm_phase<pg8::EpiStore, pg8::StaticOrder>(ring, g, S, E, F.wave); }
            { pg8::Gemm g{(const b16*)(F.ws + WS_YB), (const b16*)(F.ws + W_UPB), 256}; pg8::StaticOrder S; S.init(T, D, F.G, (int)blockIdx.x); pg8::EpiStore E{(b16*)(F.ws + WS_R3) + 1024, 3072}; pg8::gemm_phase<pg8::EpiStore, pg8::StaticOrder>(ring, g, S, E, F.wave); }
            { pg8::Gemm g{(const b16*)(F.ws + WS_YC), (const b16*)(F.ws + W_UPC), 512}; pg8::StaticOrder S; S.init(T, D, F.G, (int)blockIdx.x); pg8::EpiStore E{(b16*)(F.ws + WS_R3) + 2048, 3072}; pg8::gemm_phase<pg8::EpiStore, pg8::StaticOrder>(ring, g, S, E, F.wave); }
        }
#if DIAG == 22
        if (l == 0) { xcd_barrier(bar); emit_frac(F, (const bf16*)(F.ws + WS_R3), 0, (size_t)T * D); return; }
#endif
        SEAM(pb + 6);
        for (int rep = 0; rep <= ((REPMASK >> 7) & 1); ++rep) if (rep_prologue(F, bar, rep)) if (!((DISABLE >> 7) & 1) && IN(pb + 7)) { pg8::Gemm g{(const b16*)(F.ws + WS_H), (const b16*)(F.ws + W_IN) + (size_t)PW * D, D}; pg8::GateOrder S{F.G, F.vcu};
            pg8::EpiGate E{(const b16*)(F.ws + WS_R3), (b16*)(F.ws + WS_MRG)}; pg8::gemm_phase<pg8::EpiGate, pg8::GateOrder>(ring, g, S, E, F.wave); }
#if DIAG == 23
        if (l == 0) { xcd_barrier(bar); emit_frac(F, (const bf16*)(F.ws + WS_MRG), 0, (size_t)T * D); return; }
#endif
        SEAM(pb + 7);
        for (int rep = 0; rep <= ((REPMASK >> 8) & 1); ++rep) if (rep_prologue(F, bar, rep)) if (!((DISABLE >> 8) & 1) && IN(pb + 8)) { pg8::Gemm g{(const b16*)(F.ws + WS_MRG), (const b16*)(F.ws + W_OUT), D}; pg8::StaticOrder S; S.init(T, D, F.G, (int)blockIdx.x);
            pg8::EpiOut E{(const b16*)(F.ws + WS_H), (b16*)(F.ws + WS_R3)}; pg8::gemm_phase<pg8::EpiOut, pg8::StaticOrder>(ring, g, S, E, F.wave); }
#if DIAG == 24
        if (l == 0) { xcd_barrier(bar); emit_frac(F, (const bf16*)(F.ws + WS_R3), 0, (size_t)T * D); return; }
#endif
        SEAM(pb + 8);
        for (int rep = 0; rep <= ((REPMASK >> 9) & 1); ++rep) if (rep_prologue(F, bar, rep)) if (!((DISABLE >> 9) & 1) && IN(pb + 9)) ln1_route_phase(F, l);
#if DIAG == 11
        if (l == 0) return;
#endif
#if DIAG == 10
        if (l == 0) { LAS int* sel_e = (LAS int*)(F.lds + 65536); LAS float* sel_g = (LAS float*)(F.lds + 65536 + 1024); LAS int* rnk = (LAS int*)(F.lds + 65536 + 2048);
            for (int i = F.tid; i < 128 * 1024; i += NWAVES * 64) { const int tl = i >> 10, c = i & 1023; float v = 0.f;
                if (c < 2) v = (float)sel_e[2 * tl + c]; else if (c < 4) v = sel_g[2 * tl + c - 2]; else if (c < 6) v = (float)rnk[2 * tl + c - 4];
                F.out[(size_t)(blockIdx.x * 128 + tl) * 1024 + c] = v; } return; }
#endif
#if DIAG == 6
        if (l == 0) { xcd_barrier(bar); const bf16* Hd = (const bf16*)(F.ws + WS_H); const size_t n = (size_t)T * D, nth = (size_t)F.G * NWAVES * 64;
            for (size_t i = (size_t)blockIdx.x * (NWAVES * 64) + F.tid; i < n; i += nth) F.out[i] = bf2f(Hd[i]); return; }
#endif
        SEAM(pb + 9);
        for (int rep = 0; rep <= ((REPMASK >> 10) & 1); ++rep) if (rep_prologue(F, bar, rep)) if (!((DISABLE >> 10) & 1) && IN(pb + 10)) dispatch_phase(F);
#if DIAG == 9
        if (l == 0) { xcd_barrier(bar); volatile LAS int* tabd = (volatile LAS int*)(F.MISC + 16); moe_table(F, tabd); const int* lst = (const int*)(F.ws + WS_LIST); const size_t n = (size_t)T * D, nth = (size_t)F.G * NWAVES * 64;
            for (size_t i = (size_t)blockIdx.x * (NWAVES * 64) + F.tid; i < n; i += nth) { const int k = (int)(i & 524287), e = k >> 15, pos = k & 32767; F.out[i] = pos < tabd[e] ? (float)(lst[k] & 1023) : -1.0f; } return; }
#endif
        SEAM(pb + 10);
        for (int rep = 0; rep <= ((REPMASK >> 11) & 1); ++rep) if (rep_prologue(F, bar, rep)) if (!((DISABLE >> 11) & 1) && IN(pb + 11)) { volatile LAS int* tab = (volatile LAS int*)(F.MISC + 16); const int NP = moe_table(F, tab);
            pg8::Gemm g{(const b16*)(F.ws + WS_H), (const b16*)(F.ws + W_13), D}; pg8::MoeOrder S{tab, (const int*)(F.ws + WS_LIST), 8, F.G, F.vcu, NP};
            pg8::EpiFfn1 E{(b16*)(F.ws + WS_R3)}; pg8::gemm_phase<pg8::EpiFfn1, pg8::MoeOrder, true>(ring, g, S, E, F.wave); }
#if DIAG == 8
        if (l == 0) { xcd_barrier(bar); const bf16* Hd = (const bf16*)(F.ws + WS_R3); const size_t n = (size_t)T * D, nth = (size_t)F.G * NWAVES * 64;
            for (size_t i = (size_t)blockIdx.x * (NWAVES * 64) + F.tid; i < n; i += nth) F.out[i] = bf2f(Hd[i]); return; }
#endif
        SEAM(pb + 11);
        for (int rep = 0; rep <= ((REPMASK >> 12) & 1); ++rep) if (rep_prologue(F, bar, rep)) if (!((DISABLE >> 12) & 1) && IN(pb + 12)) { volatile LAS int* tab = (volatile LAS int*)(F.MISC + 16); const int NP = moe_table(F, tab);
            pg8::Gemm g{(const b16*)(F.ws + WS_R3), (const b16*)(F.ws + W_2), FF}; pg8::MoeOrder S{tab, (const int*)(F.ws + WS_LIST), 4, F.G, F.vcu, NP};
            pg8::EpiFfn2 E{(const int*)(F.ws + WS_LIST), (const float*)(F.ws + WS_LIST + 2 * MiB), (b16*)F.out}; pg8::gemm_phase<pg8::EpiFfn2, pg8::MoeOrder>(ring, g, S, E, F.wave); }
        SEAM(pb + 12);
        for (int rep = 0; rep <= ((REPMASK >> 13) & 1); ++rep) if (rep_prologue(F, bar, rep)) if (!((DISABLE >> 13) & 1) && IN(pb + 13)) ln2_phase(F, l, l == NLAYER - 1);
#if DIAG == 7
        if (l == 0) { xcd_barrier(bar); const bf16* Hd = (const bf16*)(F.ws + WS_H); const size_t n = (size_t)T * D, nth = (size_t)F.G * NWAVES * 64;
            for (size_t i = (size_t)blockIdx.x * (NWAVES * 64) + F.tid; i < n; i += nth) F.out[i] = bf2f(Hd[i]); return; }
#endif
        if (l + 1 < NLAYER) SEAM(pb + 13);
    }
#undef IN
#undef SEAM
}

extern "C" void kernel_launch(void* const* d_in, const int* in_sizes, int n_in, void* d_out, int out_size, void* d_ws, size_t ws_size, hipStream_t stream) {
    static int grid = 0;
    if (grid == 0) {
        if (n_in != 28 || in_sizes[0] != T * D || out_size != T * D || ws_size < WS_END) { fprintf(stderr, "kernel_launch: unexpected shapes (n_in %d, in0 %d, out %d, ws %zu < %zu)\n", n_in, n_in > 0 ? in_sizes[0] : -1, out_size, ws_size, (size_t)WS_END); grid = -1; return; }
        int dev = 0, cus = 0, per_cu = 0;
        if (hipGetDevice(&dev) != hipSuccess || hipDeviceGetAttribute(&cus, hipDeviceAttributeMultiprocessorCount, dev) != hipSuccess) { grid = -1; return; }
        if (hipFuncSetAttribute((const void*)hse_fwd, hipFuncAttributeMaxDynamicSharedMemorySize, LDS_BYTES) != hipSuccess) { fprintf(stderr, "kernel_launch: hipFuncSetAttribute(%d) failed\n", LDS_BYTES); grid = -1; return; }
        if (hipOccupancyMaxActiveBlocksPerMultiprocessor(&per_cu, (const void*)hse_fwd, NWAVES * 64, LDS_BYTES) != hipSuccess || per_cu < 1) fprintf(stderr, "kernel_launch: occupancy query reports %d\n", per_cu);
        (void)hipGetLastError();
        if (cus < T / 128) { fprintf(stderr, "kernel_launch: needs %d CUs, device has %d\n", T / 128, cus); grid = -1; return; }
        grid = T / 128;
    }
    if (grid < 0) return;
    (void)hipMemsetAsync((char*)d_ws + WS_CTL, 0, CTL_ZERO_BYTES, stream);
    Args a{};
    for (int i = 0; i < 28; ++i) a.in[i] = (const float*)d_in[i];
    a.out = (float*)d_out; a.ws = (unsigned char*)d_ws;
#if N_LAUNCH == 1
    a.ph_lo = 0; a.ph_hi = N_PHASES;
    hipLaunchKernelGGL(hse_fwd, dim3(grid), dim3(NWAVES * 64), LDS_BYTES, stream, a);
#else
    for (int p = 0; p < N_PHASES; ++p) { a.ph_lo = p; a.ph_hi = p + 1; hipLaunchKernelGGL(hse_fwd, dim3(grid), dim3(NWAVES * 64), LDS_BYTES, stream, a); }
#endif
}
```
